# Optimizing an MI355X kernel written in HIP

```python
import math
import jax, jax.numpy as jnp
from jax import lax
import numpy as np

D_MODEL = 1024
BATCH = 4
SEQ = 8192
DEPTH = 4

N_MEM = 256
HEAD_DIM = 64
BRANCH_W = D_MODEL // 4
N_BRANCH = 5
MIX_W = N_BRANCH * BRANCH_W
N_HEADS_BR = BRANCH_W // HEAD_DIM
CHUNK = 64

GLA_RANK = 16
GLA_TAU = 16.0

SSD_NGROUPS = 2
SSD_STATE = 64
SSD_CONV = 4
SSD_XBC = BRANCH_W + 2 * SSD_NGROUPS * SSD_STATE

S5_GROUP = 16
S5_NGROUPS = BRANCH_W // S5_GROUP
S5_STATE = 64

RWKV_W_RANK = 64
RWKV_A_RANK = 64
RWKV_V_RANK = 32
RWKV_WIDTHS = (BRANCH_W, BRANCH_W, BRANCH_W, RWKV_W_RANK, RWKV_A_RANK)
RWKV_SHIFT_W = sum(RWKV_WIDTHS)
RWKV_GN_EPS = 64e-5

MEM_HEADS = 4

COL_WIDTHS = (MIX_W, BRANCH_W, BRANCH_W, BRANCH_W, GLA_RANK, SSD_XBC, N_HEADS_BR,
              BRANCH_W, RWKV_SHIFT_W, BRANCH_W)
C_BASE = sum(COL_WIDTHS)
C_FULL = C_BASE + RWKV_V_RANK

DEEPNORM_ALPHA = (2.0 * DEPTH) ** 0.25
DEEPNORM_BETA = (8.0 * DEPTH) ** -0.25
LN_EPS = 1e-5
RMS_EPS = 1e-6
F32 = jnp.float32

kernel_name = 'hybrid_parallel_heads_deepnorm'


def _split(p, widths):
    idx = np.cumsum(widths)[:-1].tolist()
    return jnp.split(p, idx, axis=-1)


def _layer_norm(x, w, b):
    xf = x.astype(F32)
    mu = jnp.mean(xf, -1, keepdims=True)
    var = jnp.mean(jnp.square(xf - mu), -1, keepdims=True)
    return ((xf - mu) * lax.rsqrt(var + LN_EPS) * w + b).astype(x.dtype)


def _head_rms_norm(y, w):
    y = y * lax.rsqrt(jnp.mean(y * y, -1, keepdims=True) + RMS_EPS)
    return y.reshape(*y.shape[:-2], -1) * w


def _chunk_states(decay, contrib):
    def step(s, inp):
        d, c = inp
        return d * s + c, s
    init = jnp.zeros_like(contrib[:, 0])
    _, prev = lax.scan(step, init, (jnp.moveaxis(decay, 1, 0), jnp.moveaxis(contrib, 1, 0)))
    return jnp.moveaxis(prev, 0, 1)


def _causal_mask():
    return jnp.tril(jnp.ones((CHUNK, CHUNK), dtype=bool))


def _gla(q, k, v, a_low, w_a2, b_a, norm_w):
    Bn, S, _ = q.shape
    nc = S // CHUNK
    def heads(t):
        return t.astype(F32).reshape(Bn, nc, CHUNK, N_HEADS_BR, HEAD_DIM)
    log_a = jax.nn.log_sigmoid((a_low @ w_a2 + b_a).astype(F32)) / GLA_TAU
    q = heads(q) * HEAD_DIM ** -0.5
    k, v, log_a = heads(k), heads(v), heads(log_a)
    b = jnp.cumsum(log_a, axis=2)
    b_last = b[:, :, -1:]
    qe = q * jnp.exp(b)
    ke = k * jnp.exp(-b)
    kl = k * jnp.exp(b_last - b)
    att = jnp.einsum('bclhk,bcshk->bchls', qe, ke)
    att = jnp.where(_causal_mask(), att, 0.0)
    o = jnp.einsum('bchls,bcshv->bclhv', att, v)
    contrib = jnp.einsum('bcshk,bcshv->bchkv', kl, v)
    decay = jnp.exp(b_last[:, :, 0])[..., None]
    s_prev = _chunk_states(decay, contrib)
    o = o + jnp.einsum('bclhk,bchkv->bclhv', qe, s_prev)
    return _head_rms_norm(o.reshape(Bn, S, N_HEADS_BR, HEAD_DIM), norm_w)


def _ssd(xbc, dt_raw, conv_w, conv_b, dt_bias, A_log, D, norm_w):
    Bn, S, _ = xbc.shape
    nc = S // CHUNK
    xbc = lax.conv_general_dilated(xbc, conv_w[:, None, :], window_strides=(1,),
                                   padding=[(SSD_CONV - 1, 0)],
                                   dimension_numbers=('NWC', 'WIO', 'NWC'),
                                   feature_group_count=SSD_XBC) + conv_b
    xbc = jax.nn.silu(xbc.astype(F32))
    xs, Bm, Cm = _split(xbc, (BRANCH_W, SSD_NGROUPS * SSD_STATE, SSD_NGROUPS * SSD_STATE))
    rep = N_HEADS_BR // SSD_NGROUPS
    xs = xs.reshape(Bn, nc, CHUNK, N_HEADS_BR, HEAD_DIM)
    Bm = jnp.repeat(Bm.reshape(Bn, nc, CHUNK, SSD_NGROUPS, SSD_STATE), rep, axis=3)
    Cm = jnp.repeat(Cm.reshape(Bn, nc, CHUNK, SSD_NGROUPS, SSD_STATE), rep, axis=3)
    dt = jax.nn.softplus((dt_raw + dt_bias).astype(F32)).reshape(Bn, nc, CHUNK, N_HEADS_BR)
    A = -jnp.exp(A_log.astype(F32))
    acum = jnp.cumsum(dt * A, axis=2)
    xdt = xs * dt[..., None]
    seg = acum[:, :, :, None, :] - acum[:, :, None, :, :]
    Lmat = jnp.exp(jnp.where(_causal_mask()[:, :, None], seg, -jnp.inf))
    scores = jnp.einsum('bclhn,bcshn->bclsh', Cm, Bm) * Lmat
    y = jnp.einsum('bclsh,bcshp->bclhp', scores, xdt)
    decay_in = jnp.exp(acum[:, :, -1:] - acum)
    contrib = jnp.einsum('bclhn,bclh,bclhp->bchpn', Bm, decay_in, xdt)
    decay = jnp.exp(acum[:, :, -1])[..., None, None]
    s_prev = _chunk_states(decay, contrib)
    y = y + jnp.einsum('bclhn,bchpn,bclh->bclhp', Cm, s_prev, jnp.exp(acum))
    y = y + D.astype(F32)[:, None] * xs
    return _head_rms_norm(y.reshape(Bn, S, N_HEADS_BR, HEAD_DIM), norm_w)


def _s5(u, A_re, A_im, B_re, B_im, C_re, C_im, log_dt, D, glu_w, glu_b):
    Bn, S, _ = u.shape
    uf = u.astype(F32)
    ug = uf.reshape(Bn, S, S5_NGROUPS, S5_GROUP)
    A = lax.complex(A_re.astype(F32), A_im.astype(F32))
    dt = jnp.exp(log_dt.astype(F32))[:, None]
    A_bar = jnp.exp(A * dt)
    Bc = lax.complex(B_re.astype(F32), B_im.astype(F32))
    B_bar = ((A_bar - 1.0) / A)[..., None] * Bc
    Bu = jnp.einsum('gph,bsgh->bsgp', B_bar, ug)
    a_elems = jnp.broadcast_to(A_bar, Bu.shape)
    def combine(left, right):
        a_l, b_l = left
        a_r, b_r = right
        return a_r * a_l, a_r * b_l + b_r
    _, states = lax.associative_scan(combine, (a_elems, Bu), axis=1)
    Cc = lax.complex(C_re.astype(F32), C_im.astype(F32))
    y = jnp.einsum('ghp,bsgp->bsgh', Cc, states).real.reshape(Bn, S, BRANCH_W) + D * uf
    y = jax.nn.gelu(y)
    val, gate = _split(y @ glu_w + glu_b, (BRANCH_W, BRANCH_W))
    return val * jax.nn.sigmoid(gate)


def _token_shift(p):
    return jnp.pad(p, ((0, 0), (1, 0), (0, 0)))[:, :-1]


def _rwkv7(r, k, v, w_low, a_low, w0, w2, a0, a2, k_k, k_a, r_k, gn_w, gn_b):
    Bn, S, _ = r.shape
    def heads(t):
        return t.astype(F32).reshape(Bn, S, N_HEADS_BR, HEAD_DIM)
    def hp(t):
        return t.astype(F32).reshape(N_HEADS_BR, HEAD_DIM)
    w = -jax.nn.softplus(-(w0 + jnp.tanh(w_low) @ w2).astype(F32)) - 0.5
    decay = heads(jnp.exp(-jnp.exp(w)))
    a = heads(jax.nn.sigmoid((a0 + a_low @ a2).astype(F32)))
    r, k, v = heads(r), heads(k), heads(v)
    kk = k * hp(k_k)
    kk = kk * lax.rsqrt(jnp.sum(kk * kk, -1, keepdims=True) + 1e-12)
    k = k * (1.0 + (a - 1.0) * hp(k_a))
    def step(state, inp):
        r_t, w_t, k_t, v_t, kk_t, a_t = inp
        sa = jnp.einsum('bhvk,bhk->bhv', state, -kk_t)
        state = (state * w_t[:, :, None, :]
                 + sa[..., None] * (kk_t * a_t)[:, :, None, :]
                 + v_t[..., None] * k_t[:, :, None, :])
        return state, jnp.einsum('bhvk,bhk->bhv', state, r_t)
    seq_major = tuple(jnp.moveaxis(t, 1, 0) for t in (r, decay, k, v, kk, a))
    s0 = jnp.zeros((Bn, N_HEADS_BR, HEAD_DIM, HEAD_DIM), F32)
    _, y = lax.scan(step, s0, seq_major)
    y = jnp.moveaxis(y, 0, 1)
    mu = jnp.mean(y, -1, keepdims=True)
    var = jnp.mean(jnp.square(y - mu), -1, keepdims=True)
    y = ((y - mu) * lax.rsqrt(var + RWKV_GN_EPS)).reshape(Bn, S, BRANCH_W) * gn_w + gn_b
    bonus = jnp.sum(r * k * hp(r_k), -1, keepdims=True) * v
    return y + bonus.reshape(Bn, S, BRANCH_W)


def _mem_attn(q, mem, w_kv):
    Bn, S, _ = q.shape
    n_mem = mem.shape[1]
    km, vm = _split(mem @ w_kv, (BRANCH_W, BRANCH_W))
    q = q.reshape(Bn, S, MEM_HEADS, HEAD_DIM)
    km = km.reshape(Bn, n_mem, MEM_HEADS, HEAD_DIM)
    vm = vm.reshape(Bn, n_mem, MEM_HEADS, HEAD_DIM)
    scores = jnp.einsum('bshd,bmhd->bhsm', q, km).astype(F32) * HEAD_DIM ** -0.5
    probs = jax.nn.softmax(scores, axis=-1).astype(vm.dtype)
    return jnp.einsum('bhsm,bmhd->bshd', probs, vm).reshape(Bn, S, BRANCH_W)


def setup_inputs(seed: int = 0) -> dict:
    key = jax.random.key(seed)
    ks = iter(jax.random.split(key, 64))
    def nrm(shape, scale=1.0):
        return scale * jax.random.normal(next(ks), shape, F32)
    def unif(shape, lo, hi):
        return jax.random.uniform(next(ks), shape, F32, lo, hi)
    L, D, W = DEPTH, D_MODEL, BRANCH_W
    G, P = S5_NGROUPS, S5_STATE
    dt0 = jnp.exp(unif((L, N_HEADS_BR), math.log(1e-3), math.log(1e-1)))
    return {
        'x': nrm((BATCH, SEQ, D)),
        'mem': nrm((BATCH, N_MEM, D)),
        'w_in_first': nrm((D, C_BASE), D ** -0.5),
        'w_in_rest': nrm((L - 1, D, C_FULL), D ** -0.5),
        'gla_w_a2': nrm((L, GLA_RANK, W), GLA_RANK ** -0.5),
        'gla_b_a': 1.0 + nrm((L, W), 0.1),
        'gla_norm_w': 1.0 + nrm((L, W), 0.01),
        'ssd_conv_w': nrm((L, SSD_CONV, SSD_XBC), SSD_CONV ** -0.5),
        'ssd_conv_b': nrm((L, SSD_XBC), 0.01),
        'ssd_dt_bias': dt0 + jnp.log(-jnp.expm1(-dt0)),
        'ssd_A_log': jnp.log(unif((L, N_HEADS_BR), 1.0, 16.0)),
        'ssd_D': 1.0 + nrm((L, N_HEADS_BR), 0.01),
        'ssd_norm_w': 1.0 + nrm((L, W), 0.01),
        's5_A_re': -0.5 + nrm((L, G, P), 0.01),
        's5_A_im': np.pi * jnp.arange(P, dtype=F32) + nrm((L, G, P), 0.01),
        's5_B_re': nrm((L, G, P, S5_GROUP), (2.0 * S5_GROUP) ** -0.5),
        's5_B_im': nrm((L, G, P, S5_GROUP), (2.0 * S5_GROUP) ** -0.5),
        's5_C_re': nrm((L, G, S5_GROUP, P), (2.0 * P) ** -0.5),
        's5_C_im': nrm((L, G, S5_GROUP, P), (2.0 * P) ** -0.5),
        's5_log_dt': unif((L, G), math.log(1e-3), math.log(1e-1)),
        's5_D': nrm((L, W)),
        's5_glu_w': nrm((L, W, 2 * W), W ** -0.5),
        's5_glu_b': nrm((L, 2 * W), 0.01),
        'rwkv_mu': unif((L, RWKV_SHIFT_W), 0.0, 1.0),
        'rwkv_w0': unif((L, W), -6.0, 1.0),
        'rwkv_w2': nrm((L, RWKV_W_RANK, W), 0.1),
        'rwkv_a0': nrm((L, W), 0.1),
        'rwkv_a2': nrm((L, RWKV_A_RANK, W), 0.1),
        'rwkv_v0': 1.0 + nrm((L - 1, W), 0.1),
        'rwkv_v2': nrm((L - 1, RWKV_V_RANK, W), 0.1),
        'rwkv_k_k': 0.85 + nrm((L, W), 0.02),
        'rwkv_k_a': 1.0 + nrm((L, W), 0.02),
        'rwkv_r_k': nrm((L, W), 0.1),
        'rwkv_gn_w': 1.0 + nrm((L, W), 0.01),
        'rwkv_gn_b': nrm((L, W), 0.01),
        'mem_w_kv': nrm((L, D, 2 * W), D ** -0.5),
        'w_out': nrm((L, MIX_W, D), DEEPNORM_BETA * MIX_W ** -0.5),
        'ln_w': 1.0 + nrm((L, D), 0.01),
        'ln_b': nrm((L, D), 0.01),
    }


def reference(x, mem, w_in_first, w_in_rest, gla_w_a2, gla_b_a, gla_norm_w,
              ssd_conv_w, ssd_conv_b, ssd_dt_bias, ssd_A_log, ssd_D, ssd_norm_w,
              s5_A_re, s5_A_im, s5_B_re, s5_B_im, s5_C_re, s5_C_im, s5_log_dt, s5_D,
              s5_glu_w, s5_glu_b, rwkv_mu, rwkv_w0, rwkv_w2, rwkv_a0, rwkv_a2, rwkv_v0,
              rwkv_v2, rwkv_k_k, rwkv_k_a, rwkv_r_k, rwkv_gn_w, rwkv_gn_b, mem_w_kv,
              w_out, ln_w, ln_b):
    out_dtype = x.dtype
    v_first = None
    for l in range(DEPTH):
        w_in = w_in_first if l == 0 else w_in_rest[l - 1]
        p = x @ w_in
        (gate, gla_q, gla_k, gla_v, gla_a, ssd_xbc, ssd_dt, s5_u, rwkv_p,
         mem_q) = _split(p[..., :C_BASE], COL_WIDTHS)

        y_a = _gla(gla_q, gla_k, gla_v, gla_a, gla_w_a2[l], gla_b_a[l], gla_norm_w[l])
        y_b = _ssd(ssd_xbc, ssd_dt, ssd_conv_w[l], ssd_conv_b[l], ssd_dt_bias[l],
                   ssd_A_log[l], ssd_D[l], ssd_norm_w[l])
        y_c = _s5(s5_u, s5_A_re[l], s5_A_im[l], s5_B_re[l], s5_B_im[l], s5_C_re[l],
                  s5_C_im[l], s5_log_dt[l], s5_D[l], s5_glu_w[l], s5_glu_b[l])

        rw = rwkv_p + (_token_shift(rwkv_p) - rwkv_p) * rwkv_mu[l]
        rk_r, rk_k, rk_v, rk_w, rk_a = _split(rw, RWKV_WIDTHS)
        if l == 0:
            v_first = rk_v
        else:
            vmix = jax.nn.sigmoid(rwkv_v0[l - 1] + p[..., C_BASE:] @ rwkv_v2[l - 1])
            rk_v = rk_v + (v_first - rk_v) * vmix
        y_d = _rwkv7(rk_r, rk_k, rk_v, rk_w, rk_a, rwkv_w0[l], rwkv_w2[l], rwkv_a0[l],
                     rwkv_a2[l], rwkv_k_k[l], rwkv_k_a[l], rwkv_r_k[l], rwkv_gn_w[l],
                     rwkv_gn_b[l])
        y_m = _mem_attn(mem_q, mem, mem_w_kv[l])

        y = jnp.concatenate([t.astype(out_dtype) for t in (y_a, y_b, y_c, y_d, y_m)], axis=-1)
        y = y * jax.nn.silu(gate)
        x = _layer_norm(DEEPNORM_ALPHA * x + y @ w_out[l], ln_w[l], ln_b[l])
    return x
```

```cpp
#include <hip/hip_runtime.h>
#include <hip/hip_cooperative_groups.h>
#include <cstdio>
namespace cg = cooperative_groups;

#ifndef MK_ONE
#define MK_ONE 1
#endif

typedef unsigned short u16;
using bf16x8 = __attribute__((ext_vector_type(8))) short;
using f32x4 = __attribute__((ext_vector_type(4))) float;

constexpr int NTOK = 32768, SEQ = 8192, NL = 4;
constexpr int PC = 4032;
constexpr int C_GQ = 1280, C_GK = 1536, C_GV = 1792, C_XBC = 2048, C_S5U = 2560, C_RW = 2816, C_MQ = 3712,
              C_GA = 3968, C_DT = 3984, C_VL = 4000;
constexpr int NSEG = 64, SEGLEN = 128;
constexpr float ALPHA = 1.6817928305074290f;

enum { I_X, I_MEM, I_WIN0, I_WINR, I_GLA_WA2, I_GLA_BA, I_GLA_NW, I_SSD_CW, I_SSD_CB, I_SSD_DTB, I_SSD_ALOG, I_SSD_D,
       I_SSD_NW, I_S5_ARE, I_S5_AIM, I_S5_BRE, I_S5_BIM, I_S5_CRE, I_S5_CIM, I_S5_LOGDT, I_S5_D, I_S5_GLUW, I_S5_GLUB,
       I_RW_MU, I_RW_W0, I_RW_W2, I_RW_A0, I_RW_A2, I_RW_V0, I_RW_V2, I_RW_KK, I_RW_KA, I_RW_RK, I_RW_GNW, I_RW_GNB,
       I_MEM_WKV, I_WOUT, I_LNW, I_LNB, N_IN };

struct Params {
  const float* in[N_IN];
  float* out;
  unsigned char* ws;
  int probe;
  int dry;
};

constexpr size_t SZ_P = (size_t)NTOK * PC * 2;
constexpr size_t OFF_P = 0;
constexpr size_t OFF_WIN = OFF_P + SZ_P;
constexpr size_t OFF_WOUT = OFF_WIN + (size_t)1 * 4096 * 1024 * 2;
constexpr size_t OFF_GLU = OFF_WOUT + (size_t)4 * 1024 * 1280 * 2;
constexpr size_t OFF_MKV = OFF_GLU + (size_t)4 * 512 * 256 * 2;
constexpr size_t OFF_S5A = OFF_MKV + (size_t)4 * 512 * 1024 * 2;
constexpr size_t OFF_S5A64 = OFF_S5A + 4 * 16 * 64 * 2 * 4;
constexpr size_t OFF_S5B = OFF_S5A64 + 4 * 16 * 64 * 2 * 4;
constexpr size_t OFF_S5C = OFF_S5B + (size_t)4 * 16 * 128 * 32 * 2;
constexpr size_t OFF_KM = OFF_S5C + (size_t)4 * 16 * 16 * 128 * 2;
constexpr size_t OFF_VMT = OFF_KM + (size_t)4 * 1024 * 256 * 2;
constexpr size_t OFF_PREP = OFF_VMT + (size_t)4 * 4 * 256 * 256 * 2;
constexpr size_t SZ_PREP1 = (size_t)NTOK * 256 * 2;
constexpr size_t OFF_VF = OFF_PREP + 6 * SZ_PREP1;
constexpr size_t OFF_GST = OFF_VF + SZ_PREP1;
constexpr size_t SZ_ST = (size_t)4 * 128 * 4 * 4096 * 4;
constexpr size_t OFF_GDC = OFF_GST + SZ_ST;
constexpr size_t SZ_DC = (size_t)4 * 128 * 4 * 64 * 4;
constexpr size_t OFF_SST = OFF_GDC + SZ_DC;
constexpr size_t OFF_SDC = OFF_SST + SZ_ST;
constexpr size_t OFF_S5X = OFF_SDC + SZ_DC;
constexpr size_t OFF_RSL = OFF_S5X + (size_t)4 * 128 * 16 * 64 * 2 * 4;
constexpr size_t SZ_RS = (size_t)16 * NSEG * 4096 * 4;
constexpr size_t OFF_RPM = OFF_RSL + SZ_RS;
constexpr size_t OFF_BAR = OFF_RPM + SZ_RS;
constexpr size_t OFF_MEMB = OFF_BAR + 16384;
constexpr size_t OFF_LNX = OFF_MEMB + (size_t)1024 * 1024 * 2;
constexpr size_t OFF_W2T = OFF_LNX + (size_t)256 * 4 * 128 * 8;
constexpr size_t OFF_A2T = OFF_W2T + (size_t)4 * 256 * 64 * 2;
constexpr size_t OFF_V2T = OFF_A2T + (size_t)4 * 256 * 64 * 2;
constexpr size_t OFF_W2L = OFF_V2T + (size_t)3 * 256 * 32 * 2;
constexpr size_t WS_TOTAL = OFF_W2L + (size_t)4 * 256 * 64 * 2;

constexpr int SMEM_BYTES = 49152;

__device__ __forceinline__ int tidx() { int t = threadIdx.x; asm volatile("" : "+v"(t)); return t; }
__device__ __forceinline__ u16 f2bf(float f) {
  unsigned u = __float_as_uint(f);
  u += 0x7fffu + ((u >> 16) & 1u);
  return (u16)(u >> 16);
}
__device__ __forceinline__ float bf2f(u16 h) { return __uint_as_float(((unsigned)h) << 16); }
__device__ __forceinline__ float sigm(float x) { return 1.f / (1.f + __expf(-x)); }
__device__ __forceinline__ float silu(float x) { return x / (1.f + __expf(-x)); }
__device__ __forceinline__ float softplus(float x) { return fmaxf(x, 0.f) + log1pf(__expf(-fabsf(x))); }
__device__ __forceinline__ float gelu_tanh(float x) {
  float u = 0.7978845608028654f * (x + 0.044715f * x * x * x);
  return 0.5f * x * (1.f + tanhf(u));
}
#define DPP_ADD(v, CTRL) ((v) + __int_as_float(__builtin_amdgcn_update_dpp(0, __float_as_int(v), (CTRL), 0xf, 0xf, false)))
__device__ __forceinline__ float wave_sum(float v) {
  v = DPP_ADD(v, 0xB1);
  v = DPP_ADD(v, 0x4E);
  v = DPP_ADD(v, 0x141);
  v = DPP_ADD(v, 0x140);
  const int iv = __float_as_int(v);
  return __int_as_float(__builtin_amdgcn_readlane(iv, 0)) + __int_as_float(__builtin_amdgcn_readlane(iv, 16)) +
         __int_as_float(__builtin_amdgcn_readlane(iv, 32)) + __int_as_float(__builtin_amdgcn_readlane(iv, 48));
}
__device__ __forceinline__ float sum16(float v) {
#pragma unroll
  for (int m = 8; m >= 1; m >>= 1) v += __shfl_xor(v, m, 64);
  return v;
}
__device__ __forceinline__ float max16(float v) {
#pragma unroll
  for (int m = 8; m >= 1; m >>= 1) v = fmaxf(v, __shfl_xor(v, m, 64));
  return v;
}

template <int NT, int KS>
__device__ __forceinline__ void mma_strip(const u16* A, int lda, const u16* Bt, int ldb, f32x4 (&acc)[NT]) {
  const int lane = tidx() & 63, fr = lane & 15, fq = lane >> 4;
#pragma unroll
  for (int ks = 0; ks < KS; ++ks) {
    bf16x8 a = *(const bf16x8*)(A + fr * lda + ks * 32 + fq * 8);
#pragma unroll
    for (int n = 0; n < NT; ++n) {
      bf16x8 b = *(const bf16x8*)(Bt + (n * 16 + fr) * ldb + ks * 32 + fq * 8);
      acc[n] = __builtin_amdgcn_mfma_f32_16x16x32_bf16(a, b, acc[n], 0, 0, 0);
    }
  }
}

template <int NT, int KS>
__device__ __forceinline__ void mma_strip_t(const u16* A, int lda, const u16* Bt, int ldb, f32x4 (&acc)[NT]) {
  const int lane = tidx() & 63, fr = lane & 15, fq = lane >> 4;
#pragma unroll
  for (int ks = 0; ks < KS; ++ks) {
    bf16x8 a = *(const bf16x8*)(A + fr * lda + ks * 32 + fq * 8);
#pragma unroll
    for (int n = 0; n < NT; ++n) {
      bf16x8 b = *(const bf16x8*)(Bt + (n * 16 + fr) * ldb + ks * 32 + fq * 8);
      acc[n] = __builtin_amdgcn_mfma_f32_16x16x32_bf16(b, a, acc[n], 0, 0, 0);
    }
  }
}
__device__ __forceinline__ uint2 pack4(float a, float b, float c, float d) {
  uint2 o;
  o.x = (unsigned)f2bf(a) | ((unsigned)f2bf(b) << 16);
  o.y = (unsigned)f2bf(c) | ((unsigned)f2bf(d) << 16);
  return o;
}
__device__ __forceinline__ void unpack4(const uint2& u, float* o) {
  o[0] = __uint_as_float(u.x << 16); o[1] = __uint_as_float(u.x & 0xffff0000u);
  o[2] = __uint_as_float(u.y << 16); o[3] = __uint_as_float(u.y & 0xffff0000u);
}

enum { EPI_P, EPI_MEMKV, EPI_OUT, EPI_GLU };

template <int EPI, bool AF32>
__device__ __forceinline__ void gemm_tile(const Params& p, int layer, const void* Av, int lda, const u16* Bt, int K, int m0, int n0,
                          unsigned char* smem) {
  u16* sA = (u16*)smem;
  u16* sB = sA + 2 * 128 * 32;
  const int tid = tidx(), lane = tid & 63, w = tid >> 6, wr = w >> 1, wc = w & 1, fr = lane & 15, fq = lane >> 4;
  f32x4 acc[4][8];
#pragma unroll
  for (int m = 0; m < 4; ++m)
#pragma unroll
    for (int n = 0; n < 8; ++n) acc[m][n] = f32x4{0.f, 0.f, 0.f, 0.f};
  uint4 qa0_0, qa0_1, qb0_0, qb0_1, qb0_2, qb0_3;
  uint4 qa1_0, qa1_1, qb1_0, qb1_1, qb1_2, qb1_3;
  const int nk = K / 32;
  const u16* Ag = (const u16*)Av;
  const int lrow = tid >> 2, lc8 = (tid & 3) * 8;
  const u16* gA = Ag + (size_t)(m0 + lrow) * lda + lc8;
  const u16* gB = Bt + (size_t)(n0 + lrow) * K + lc8;
  const size_t a64 = (size_t)64 * lda, b64 = (size_t)64 * K;
  const int sw = lrow * 32 + (((tid & 3) ^ ((lrow >> 2) & 3)) * 8);
  const int rsw = (fq ^ ((fr >> 2) & 3)) * 8;
  __syncthreads();
#define GLOAD(S, kt)                                   \
  {                                                    \
    const int k0 = (kt) * 32;                          \
    qa##S##_0 = *(const uint4*)(gA + k0);              \
    qa##S##_1 = *(const uint4*)(gA + a64 + k0);        \
    qb##S##_0 = *(const uint4*)(gB + k0);              \
    qb##S##_1 = *(const uint4*)(gB + b64 + k0);        \
    qb##S##_2 = *(const uint4*)(gB + 2 * b64 + k0);    \
    qb##S##_3 = *(const uint4*)(gB + 3 * b64 + k0);    \
  }
#define SSTORE(S, buf)                                 \
  {                                                    \
    u16* a_ = sA + (buf) * 128 * 32;                   \
    u16* b_ = sB + (buf) * 256 * 32;                   \
    *(uint4*)(a_ + sw) = qa##S##_0;                    \
    *(uint4*)(a_ + 64 * 32 + sw) = qa##S##_1;          \
    *(uint4*)(b_ + sw) = qb##S##_0;                    \
    *(uint4*)(b_ + 64 * 32 + sw) = qb##S##_1;          \
    *(uint4*)(b_ + 128 * 32 + sw) = qb##S##_2;         \
    *(uint4*)(b_ + 192 * 32 + sw) = qb##S##_3;         \
  }
#define GSTEP(U, S)                                                                                 \
  {                                                                                                 \
    const int kt = kt0 + (U);                                                                       \
    if (kt < nk) {                                                                                  \
      {                                                                                             \
        const u16* a_ = sA + (kt & 1) * 128 * 32 + (wr * 64) * 32;                                  \
        const u16* b_ = sB + (kt & 1) * 256 * 32 + (wc * 128) * 32;                                 \
        bf16x8 af[4];                                                                               \
        _Pragma("unroll") for (int m = 0; m < 4; ++m) af[m] = *(const bf16x8*)(a_ + (m * 16 + fr) * 32 + rsw);      \
        __builtin_amdgcn_s_setprio(1);                                                              \
        _Pragma("unroll") for (int nh = 0; nh < 2; ++nh) {                                          \
          bf16x8 bfr[4];                                                                            \
          _Pragma("unroll") for (int n = 0; n < 4; ++n) bfr[n] = *(const bf16x8*)(b_ + ((nh * 4 + n) * 16 + fr) * 32 + rsw); \
          _Pragma("unroll") for (int m = 0; m < 4; ++m)                                             \
            _Pragma("unroll") for (int n = 0; n < 4; ++n)                                           \
              acc[m][nh * 4 + n] = __builtin_amdgcn_mfma_f32_16x16x32_bf16(bfr[n], af[m], acc[m][nh * 4 + n], 0, 0, 0); \
        }                                                                                           \
        __builtin_amdgcn_s_setprio(0);                                                              \
      }                                                                                             \
      if (kt + 1 < nk) SSTORE(S, (kt + 1) & 1);                                                     \
      if (kt + 2 < nk) GLOAD(0, kt + 2);                                                            \
      __syncthreads();                                                                              \
    }                                                                                               \
  }
  GLOAD(0, 0);
  qa1_0 = qa1_1 = qb1_0 = qb1_1 = qb1_2 = qb1_3 = make_uint4(0, 0, 0, 0);
  if (nk > 1) GLOAD(1, 1);
  SSTORE(0, 0);
  __syncthreads();
  {
    const int kt0 = 0;
    GSTEP(0, 1);
  }
#pragma unroll 1
  for (int kt0 = 1; kt0 < nk; ++kt0) {
    GSTEP(0, 0);
  }
#undef GLOAD
#undef SSTORE
#undef GSTEP
  u16* P = (u16*)(p.ws + OFF_P);
  if (EPI == EPI_GLU) {
    const float* gb = p.in[I_S5_GLUB] + layer * 512;
#pragma unroll
    for (int m = 0; m < 4; ++m)
#pragma unroll
      for (int n2 = 0; n2 < 4; ++n2) {
        if ((n2 & 1) == 0) __builtin_amdgcn_sched_barrier(0);
        const int cb = n0 + wc * 128 + n2 * 32;
        const int c0 = (cb >> 5) * 16 + fq * 4;
        const int row = m0 + wr * 64 + m * 16 + fr;
        const size_t a = (size_t)row * PC + 512 + c0;
        const uint2 gq = *(const uint2*)(P + a);
        const float g[4] = {__uint_as_float(gq.x << 16), __uint_as_float(gq.x & 0xffff0000u),
                            __uint_as_float(gq.y << 16), __uint_as_float(gq.y & 0xffff0000u)};
        float o[4];
#pragma unroll
        for (int j = 0; j < 4; ++j) {
          float val = acc[m][n2 * 2][j] + gb[c0 + j];
          float gt = acc[m][n2 * 2 + 1][j] + gb[256 + c0 + j];
          o[j] = val * sigm(gt) * silu(g[j]);
        }
        uint2 ov;
        ov.x = (unsigned)f2bf(o[0]) | ((unsigned)f2bf(o[1]) << 16);
        ov.y = (unsigned)f2bf(o[2]) | ((unsigned)f2bf(o[3]) << 16);
        if (!p.dry) *(uint2*)(P + a) = ov;
      }
    return;
  }
  if (EPI == EPI_P) {
    u16* cw = (u16*)smem + w * (64 * 72);
#pragma unroll
    for (int nh = 0; nh < 2; ++nh) {
      if (nh) __syncthreads();
#pragma unroll
      for (int m = 0; m < 4; ++m)
#pragma unroll
        for (int n = 0; n < 4; ++n) {
          const f32x4 v = acc[m][nh * 4 + n];
          uint2 ov;
          ov.x = (unsigned)f2bf(v[0]) | ((unsigned)f2bf(v[1]) << 16);
          ov.y = (unsigned)f2bf(v[2]) | ((unsigned)f2bf(v[3]) << 16);
          *(uint2*)(cw + (m * 16 + fr) * 72 + n * 16 + fq * 4) = ov;
        }
      __syncthreads();
      const int colb = n0 + wc * 128 + nh * 64;
      if (colb < PC && !p.dry) {
#pragma unroll
        for (int i = 0; i < 8; ++i) {
          const int r = i * 8 + (lane >> 3), c8 = (lane & 7) * 8;
          const uint4 v = *(const uint4*)(cw + r * 72 + c8);
          *(uint4*)(P + (size_t)(m0 + wr * 64 + r) * PC + colb + c8) = v;
        }
      }
    }
    return;
  }
  if (EPI == EPI_OUT) {
    if (p.dry) return;
    const float* xr = (layer == 0) ? p.in[I_X] : p.out;
    float s1[4], s2[4];
#pragma unroll
    for (int m = 0; m < 4; ++m) {
      const int row = m0 + wr * 64 + m * 16 + fr;
      float a1 = 0.f, a2 = 0.f;
#pragma unroll
      for (int n = 0; n < 8; ++n) {
        const int col = n0 + wc * 128 + n * 16 + fq * 4;
        const float4 xv = *(const float4*)(xr + (size_t)row * 1024 + col);
        f32x4 z = acc[m][n];
        z[0] += ALPHA * xv.x; z[1] += ALPHA * xv.y; z[2] += ALPHA * xv.z; z[3] += ALPHA * xv.w;
        acc[m][n] = z;
        a1 += z[0] + z[1] + z[2] + z[3];
        a2 += z[0] * z[0] + z[1] * z[1] + z[2] * z[2] + z[3] * z[3];
      }
      a1 += __shfl_xor(a1, 16, 64); a1 += __shfl_xor(a1, 32, 64);
      a2 += __shfl_xor(a2, 16, 64); a2 += __shfl_xor(a2, 32, 64);
      s1[m] = a1; s2[m] = a2;
    }
    float* red = (float*)smem;
    if (fq == 0) {
#pragma unroll
      for (int m = 0; m < 4; ++m) {
        const int rl = wr * 64 + m * 16 + fr;
        red[(rl * 2 + wc) * 2] = s1[m];
        red[(rl * 2 + wc) * 2 + 1] = s2[m];
      }
    }
    __syncthreads();
    const int mt = m0 >> 7, nt = n0 >> 8;
    unsigned long long* lnx = (unsigned long long*)(p.ws + OFF_LNX);
    unsigned* cnt = (unsigned*)(p.ws + OFF_BAR) + 3584 + mt;
    if (tid < 128) {
      const float t1 = red[(tid * 2) * 2] + red[(tid * 2 + 1) * 2];
      const float t2 = red[(tid * 2) * 2 + 1] + red[(tid * 2 + 1) * 2 + 1];
      const unsigned long long pk = ((unsigned long long)__float_as_uint(t2) << 32) | (unsigned long long)__float_as_uint(t1);
      __hip_atomic_store(lnx + ((size_t)mt * 4 + nt) * 128 + tid, pk, __ATOMIC_RELAXED, __HIP_MEMORY_SCOPE_AGENT);
    }
    asm volatile("s_waitcnt vmcnt(0)" ::: "memory");
    __syncthreads();
    if (tid == 0) {
      __hip_atomic_fetch_add(cnt, 1u, __ATOMIC_RELEASE, __HIP_MEMORY_SCOPE_AGENT);
      const unsigned target = 4u * (unsigned)(layer + 1);
      unsigned spins = 0;
      while (__hip_atomic_load(cnt, __ATOMIC_RELAXED, __HIP_MEMORY_SCOPE_AGENT) < target) {
        __builtin_amdgcn_s_sleep(1);
        if (++spins > (1u << 24)) break;
      }
      __builtin_amdgcn_fence(__ATOMIC_ACQUIRE, "agent");
    }
    __syncthreads();
    const float* lw = p.in[I_LNW] + layer * 1024;
    const float* lb = p.in[I_LNB] + layer * 1024;
    u16* Xb = (u16*)(p.ws + OFF_PREP);
#pragma unroll
    for (int m = 0; m < 4; ++m) {
      const int rl = wr * 64 + m * 16 + fr;
      const int row = m0 + rl;
      float t1 = 0.f, t2 = 0.f;
#pragma unroll
      for (int q = 0; q < 4; ++q) {
        const unsigned long long pk = __hip_atomic_load(lnx + ((size_t)mt * 4 + q) * 128 + rl, __ATOMIC_RELAXED, __HIP_MEMORY_SCOPE_AGENT);
        t1 += __uint_as_float((unsigned)(pk & 0xffffffffull));
        t2 += __uint_as_float((unsigned)(pk >> 32));
      }
      const float mean = t1 * (1.f / 1024.f);
      const float var = fmaxf(t2 * (1.f / 1024.f) - mean * mean, 0.f);
      const float rs = rsqrtf(var + 1e-5f);
#pragma unroll
      for (int n = 0; n < 8; ++n) {
        const int col = n0 + wc * 128 + n * 16 + fq * 4;
        const float4 wv = *(const float4*)(lw + col);
        const float4 bv = *(const float4*)(lb + col);
        const f32x4 z = acc[m][n];
        float4 o;
        o.x = (z[0] - mean) * rs * wv.x + bv.x;
        o.y = (z[1] - mean) * rs * wv.y + bv.y;
        o.z = (z[2] - mean) * rs * wv.z + bv.z;
        o.w = (z[3] - mean) * rs * wv.w + bv.w;
        *(float4*)(p.out + (size_t)row * 1024 + col) = o;
        if (layer + 1 < NL) *(uint2*)(Xb + (size_t)row * 1024 + col) = pack4(o.x, o.y, o.z, o.w);
      }
    }
    return;
  }
#pragma unroll
  for (int m = 0; m < 4; ++m)
#pragma unroll
    for (int n = 0; n < 8; ++n) {
      if ((n & 3) == 0) __builtin_amdgcn_sched_barrier(0);
      const int row = m0 + wr * 64 + m * 16 + fr;
      const int col = n0 + wc * 128 + n * 16 + fq * 4;
      const f32x4 v = acc[m][n];
      if (EPI == EPI_MEMKV) {
        u16* km = (u16*)(p.ws + OFF_KM) + (size_t)layer * 1024 * 256;
        u16* vmT = (u16*)(p.ws + OFF_VMT) + (size_t)layer * 4 * 256 * 256;
        if (!p.dry) {
#pragma unroll
          for (int j = 0; j < 4; ++j) {
            int cj = col + j;
            if (cj < 256) km[(size_t)row * 256 + cj] = f2bf(v[j]);
            else {
              int b = row >> 8, mm = row & 255;
              vmT[((size_t)b * 256 + (cj - 256)) * 256 + mm] = f2bf(v[j]);
            }
          }
        }
      } else if (EPI == EPI_OUT) {
        const float* xr = (layer == 0) ? p.in[I_X] : p.out;
        const size_t a = (size_t)row * 1024 + col;
        const float4 xv = *(const float4*)(xr + a);
        float4 o;
        o.x = ALPHA * xv.x + v[0]; o.y = ALPHA * xv.y + v[1]; o.z = ALPHA * xv.z + v[2]; o.w = ALPHA * xv.w + v[3];
        if (!p.dry) *(float4*)(p.out + a) = o;
      }
    }
}

__device__ __forceinline__ int win_src_col(int n, int layer) {
  if (n < 2048) return n;
  if (n < 2560) return n - 2048 + 2064;
  if (n < 2816) return n - 2560 + 2580;
  if (n < 3712) return n - 2816 + 2836;
  if (n < 3968) return n - 3712 + 3732;
  if (n < 3984) return n - 3968 + 2048;
  if (n < 3988) return n - 3984 + 2576;
  if (n < 4000) return -1;
  if (n < 4032) return layer == 0 ? -1 : (n - 4000 + 3988);
  return -1;
}
__device__ __forceinline__ void tconv_tile(const float* src, int src_ld, u16* dst, int K, int n0, int k0, int kind, int layer, float* tile, int dry = 0) {
  const int tid = tidx();
  __syncthreads();
  {
    int nn = tid & 63, n = n0 + nn;
    int sc;
    if (kind == 0) sc = win_src_col(n, layer);
    else if (kind == 1) sc = n;
    else sc = ((n >> 5) * 16 + (n & 15)) + 256 * ((n >> 4) & 1);
#pragma unroll
    for (int i = 0; i < 16; ++i) {
      int kk = (tid >> 6) + 4 * i;
      float v = (sc >= 0) ? src[(size_t)(k0 + kk) * src_ld + sc] : 0.f;
      tile[kk * 65 + nn] = v;
    }
  }
  __syncthreads();
  {
    int kk = tid & 63;
#pragma unroll
    for (int i = 0; i < 16; ++i) {
      int nn = (tid >> 6) + 4 * i;
      if (!dry) dst[(size_t)(n0 + nn) * K + k0 + kk] = f2bf(tile[kk * 65 + nn]);
    }
  }
}

__device__ __forceinline__ void s5_params_item(const Params& p, int l, int g) {
  const int tid = tidx();
  float* Abar = (float*)(p.ws + OFF_S5A) + ((size_t)(l * 16 + g) * 64) * 2;
  float* A64 = (float*)(p.ws + OFF_S5A64) + ((size_t)(l * 16 + g) * 64) * 2;
  u16* Bb = (u16*)(p.ws + OFF_S5B) + (size_t)(l * 16 + g) * 128 * 32;
  u16* Cm = (u16*)(p.ws + OFF_S5C) + (size_t)(l * 16 + g) * 16 * 128;
  const int pp = tid & 63, sub = tid >> 6;
  float are = p.in[I_S5_ARE][(l * 16 + g) * 64 + pp], aim = p.in[I_S5_AIM][(l * 16 + g) * 64 + pp];
  float dt = expf(p.in[I_S5_LOGDT][l * 16 + g]);
  float mag = expf(are * dt);
  float sn, cs;
  sincosf(aim * dt, &sn, &cs);
  float abr = mag * cs, abi = mag * sn;
  float nr = abr - 1.f, ni = abi;
  float den = are * are + aim * aim;
  float fr_ = (nr * are + ni * aim) / den, fi_ = (ni * are - nr * aim) / den;
  if (sub == 0) {
    Abar[pp * 2] = abr; Abar[pp * 2 + 1] = abi;
    float xr = abr, xi = abi;
#pragma unroll
    for (int i = 0; i < 6; ++i) { float t = xr * xr - xi * xi; xi = 2.f * xr * xi; xr = t; }
    A64[pp * 2] = xr; A64[pp * 2 + 1] = xi;
  }
  for (int hh = sub * 4; hh < sub * 4 + 4; ++hh) {
    size_t bi = ((size_t)(l * 16 + g) * 64 + pp) * 16 + hh;
    float bre = p.in[I_S5_BRE][bi], bim = p.in[I_S5_BIM][bi];
    Bb[pp * 32 + hh] = f2bf(fr_ * bre - fi_ * bim);
    Bb[(64 + pp) * 32 + hh] = f2bf(fr_ * bim + fi_ * bre);
    Bb[pp * 32 + 16 + hh] = 0;
    Bb[(64 + pp) * 32 + 16 + hh] = 0;
  }
  for (int hh = sub * 4; hh < sub * 4 + 4; ++hh) {
    size_t ci = ((size_t)(l * 16 + g) * 16 + hh) * 64 + pp;
    Cm[hh * 128 + pp] = f2bf(p.in[I_S5_CRE][ci]);
    Cm[hh * 128 + 64 + pp] = f2bf(-p.in[I_S5_CIM][ci]);
  }
}

__device__ __forceinline__ void cvt_bf16_rows(const Params& p, const float* src, u16* dst, size_t n4) {
  for (size_t i = (size_t)blockIdx.x * 256 + tidx(); i < n4; i += (size_t)gridDim.x * 256) {
    float4 v = ((const float4*)src)[i];
    uint2 o;
    o.x = (unsigned)f2bf(v.x) | ((unsigned)f2bf(v.y) << 16);
    o.y = (unsigned)f2bf(v.z) | ((unsigned)f2bf(v.w) << 16);
    if (!p.dry) ((uint2*)dst)[i] = o;
  }
}
__device__ __forceinline__ void phase0(const Params& p, unsigned char* smem) {
  float* tile = (float*)smem;
  cvt_bf16_rows(p, p.in[I_X], (u16*)(p.ws + OFF_PREP), (size_t)NTOK * 1024 / 4);
  cvt_bf16_rows(p, p.in[I_MEM], (u16*)(p.ws + OFF_MEMB), (size_t)1024 * 1024 / 4);
  const int T_WIN = 1 * 64 * 16, T_WOUT = 4 * 16 * 20, T_GLU = 4 * 8 * 4, T_MKV = 4 * 8 * 16, T_S5 = 64;
  const int total = T_WIN + T_WOUT + T_GLU + T_MKV + T_S5;
  for (int it = blockIdx.x; it < total; it += gridDim.x) {
    int t = it;
    if (t < T_WIN) {
      int l = t / 1024, r = t % 1024, nt = r / 16, kt = r % 16;
      const float* src = (l == 0) ? p.in[I_WIN0] : p.in[I_WINR] + (size_t)(l - 1) * 1024 * 4020;
      tconv_tile(src, l == 0 ? 3988 : 4020, (u16*)(p.ws + OFF_WIN), 1024, nt * 64, kt * 64, 0, l, tile);
      continue;
    }
    t -= T_WIN;
    if (t < T_WOUT) {
      int l = t / 320, r = t % 320, nt = r / 20, kt = r % 20;
      tconv_tile(p.in[I_WOUT] + (size_t)l * 1280 * 1024, 1024, (u16*)(p.ws + OFF_WOUT) + (size_t)l * 1024 * 1280, 1280, nt * 64, kt * 64, 1, l, tile);
      continue;
    }
    t -= T_WOUT;
    if (t < T_GLU) {
      int l = t / 32, r = t % 32, nt = r / 4, kt = r % 4;
      tconv_tile(p.in[I_S5_GLUW] + (size_t)l * 256 * 512, 512, (u16*)(p.ws + OFF_GLU) + (size_t)l * 512 * 256, 256, nt * 64, kt * 64, 2, l, tile);
      continue;
    }
    t -= T_GLU;
    if (t < T_MKV) {
      int l = t / 128, r = t % 128, nt = r / 16, kt = r % 16;
      tconv_tile(p.in[I_MEM_WKV] + (size_t)l * 1024 * 512, 512, (u16*)(p.ws + OFF_MKV) + (size_t)l * 512 * 1024, 1024, nt * 64, kt * 64, 1, l, tile);
      continue;
    }
    t -= T_MKV;
    s5_params_item(p, t / 16, t % 16);
  }
  {
    u16* W2T = (u16*)(p.ws + OFF_W2T);
    u16* A2T = (u16*)(p.ws + OFF_A2T);
    u16* V2T = (u16*)(p.ws + OFF_V2T);
    for (int i = blockIdx.x * 256 + tidx(); i < 4 * 256 * 64; i += gridDim.x * 256) {
      const int ll = i >> 14, cc = (i >> 6) & 255, j = i & 63;
      if (!p.dry) {
        const float wv_ = p.in[I_RW_W2][((size_t)ll * 64 + j) * 256 + cc];
        const u16 wh_ = f2bf(wv_);
        W2T[i] = wh_;
        ((u16*)(p.ws + OFF_W2L))[i] = f2bf(wv_ - bf2f(wh_));
        A2T[i] = f2bf(p.in[I_RW_A2][((size_t)ll * 64 + j) * 256 + cc]);
      }
    }
    for (int i = blockIdx.x * 256 + tidx(); i < 3 * 256 * 32; i += gridDim.x * 256) {
      const int ll = i >> 13, cc = (i >> 5) & 255, j = i & 31;
      if (!p.dry) V2T[i] = f2bf(p.in[I_RW_V2][((size_t)ll * 32 + j) * 256 + cc]);
    }
  }
}

__device__ __forceinline__ void phaseA(const Params& p, int l, unsigned char* smem) {
  const int T_IN = 256 * 16, T_KV = (l == 0) ? 4 * 8 * 2 : 0;
  for (int it = blockIdx.x; it < T_IN + T_KV; it += gridDim.x) {
    if (it < T_IN) {
      int mt = it / 16, nt = it % 16;
      if (gridDim.x == 512) {
        const int r = it >> 9, x = blockIdx.x & 7, k = blockIdx.x >> 3;
        mt = x * 32 + (r >> 1) * 8 + (k >> 3);
        nt = (r & 1) * 8 + (k & 7);
      }
      gemm_tile<EPI_P, false>(p, l, (const u16*)(p.ws + OFF_PREP), 1024, (const u16*)(p.ws + OFF_WIN), 1024, mt * 128, nt * 256, smem);
    } else {
      int t = it - T_IN, ll = t >> 4, mt = (t & 15) / 2, nt = t & 1;
      gemm_tile<EPI_MEMKV, false>(p, ll, (const u16*)(p.ws + OFF_MEMB), 1024, (const u16*)(p.ws + OFF_MKV) + (size_t)ll * 512 * 1024, 1024, mt * 128, nt * 256, smem);
    }
  }
}

template <bool OUT>
__device__ __forceinline__ void gla_item(const Params& p, int l, int b, int c, int h, unsigned char* smem) {
  u16* P = (u16*)(p.ws + OFF_P);
  const int tid = tidx(), lane = tid & 63, w = tid >> 6, fr = lane & 15, fq = lane >> 4;
  const int kc = lane, sq = w;
  u16* t0 = (u16*)smem;
  u16* t1 = t0 + 64 * 72;
  u16* t2 = t1 + 64 * 72;
  u16* t3 = t2 + 64 * 72;
  u16* t4 = t3 + 64 * 72;
  float* tot = (float*)(t4 + 64 * 72);
  const size_t tok0 = (size_t)b * SEQ + c * 64;
  u16* gst = (u16*)(p.ws + OFF_GST) + ((size_t)((b * 128 + c) * 4 + h)) * 4096;
  __syncthreads();
  unsigned qraw[16], kraw[16], vraw16[16];
#pragma unroll
  for (int i = 0; i < 16; ++i) {
    const size_t tok = tok0 + sq * 16 + i;
    kraw[i] = P[tok * PC + C_GK + h * 64 + kc];
    vraw16[i] = P[tok * PC + C_GV + h * 64 + kc];
    qraw[i] = OUT ? (unsigned)P[tok * PC + C_GQ + h * 64 + kc] : 0u;
  }
  uint4 spv0 = make_uint4(0, 0, 0, 0), spv1 = spv0;
  uint2 gq4[4];
  if (OUT) {
    spv0 = *(const uint4*)(gst + tid * 8);
    spv1 = *(const uint4*)(gst + (tid + 256) * 8);
#pragma unroll
    for (int n = 0; n < 4; ++n) gq4[n] = *(const uint2*)(P + (tok0 + w * 16 + fr) * PC + h * 64 + n * 16 + fq * 4);
  }
  float wa[16];
#pragma unroll
  for (int r = 0; r < 16; ++r) wa[r] = p.in[I_GLA_WA2][(size_t)(l * 16 + r) * 256 + h * 64 + kc];
  const float ba = p.in[I_GLA_BA][l * 256 + h * 64 + kc];
  float bc[16];
  float run = 0.f;
#pragma unroll
  for (int i = 0; i < 16; ++i) {
    size_t tok = tok0 + sq * 16 + i;
    const uint4* ap = (const uint4*)(P + tok * PC + C_GA);
    uint4 a0 = ap[0], a1 = ap[1];
    unsigned aw[8] = {a0.x, a0.y, a0.z, a0.w, a1.x, a1.y, a1.z, a1.w};
    float z = ba;
#pragma unroll
    for (int r = 0; r < 8; ++r) {
      z += bf2f((u16)(aw[r] & 0xffff)) * wa[2 * r];
      z += bf2f((u16)(aw[r] >> 16)) * wa[2 * r + 1];
    }
    float la = -(fmaxf(-z, 0.f) + __logf(1.f + __expf(-fabsf(z)))) * (1.f / 16.f);
    run += la;
    bc[i] = run;
  }
  tot[sq * 64 + kc] = run;
  __syncthreads();
  float prefix = 0.f, blast = 0.f;
#pragma unroll
  for (int q = 0; q < 4; ++q) {
    float t = tot[q * 64 + kc];
    if (q < sq) prefix += t;
    blast += t;
  }
  unsigned vpk[8], kpk[8];
#pragma unroll
  for (int i = 0; i < 8; ++i) { vpk[i] = 0u; kpk[i] = 0u; }
#pragma unroll
  for (int i = 0; i < 16; ++i) {
    int s = sq * 16 + i;
    size_t tok = tok0 + s;
    float bcum = bc[i] + prefix;
    float kv = bf2f((u16)kraw[i]);
    vpk[i >> 1] |= vraw16[i] << (16 * (i & 1));
    if (OUT) {
      float qv = bf2f((u16)qraw[i]) * 0.125f;
      t0[s * 72 + kc] = f2bf(qv * __expf(bcum));
      t1[s * 72 + kc] = f2bf(kv * __expf(-bcum));
    } else {
      kpk[i >> 1] |= (unsigned)f2bf(kv * __expf(blast - bcum)) << (16 * (i & 1));
    }
  }
  *(uint4*)(t2 + kc * 72 + sq * 16) = make_uint4(vpk[0], vpk[1], vpk[2], vpk[3]);
  *(uint4*)(t2 + kc * 72 + sq * 16 + 8) = make_uint4(vpk[4], vpk[5], vpk[6], vpk[7]);
  if (!OUT) {
    *(uint4*)(t0 + kc * 72 + sq * 16) = make_uint4(kpk[0], kpk[1], kpk[2], kpk[3]);
    *(uint4*)(t0 + kc * 72 + sq * 16 + 8) = make_uint4(kpk[4], kpk[5], kpk[6], kpk[7]);
  }
  if (!OUT) {
    if (!p.dry) { if (sq == 0) ((float*)(p.ws + OFF_GDC))[((size_t)((b * 128 + c) * 4 + h)) * 64 + kc] = __expf(blast); }
  } else {
    *(uint4*)(t4 + (tid >> 3) * 72 + (tid & 7) * 8) = spv0;
    *(uint4*)(t4 + ((tid + 256) >> 3) * 72 + (tid & 7) * 8) = spv1;
  }
  __syncthreads();
  f32x4 acc[4];
#pragma unroll
  for (int n = 0; n < 4; ++n) acc[n] = f32x4{0.f, 0.f, 0.f, 0.f};
  if (!OUT) {
    mma_strip_t<4, 2>(t2 + (w * 16) * 72, 72, t0, 72, acc);
    if (!p.dry) {
#pragma unroll
      for (int n = 0; n < 4; ++n)
        *(uint2*)(gst + (w * 16 + fr) * 64 + n * 16 + fq * 4) = pack4(acc[n][0], acc[n][1], acc[n][2], acc[n][3]);
    }
    return;
  }
  const int lrow = w * 16 + fr;
  mma_strip_t<4, 2>(t0 + (w * 16) * 72, 72, t1, 72, acc);
#pragma unroll
  for (int n = 0; n < 4; ++n) {
    const int sb = n * 16 + fq * 4;
    *(uint2*)(t3 + lrow * 72 + sb) = pack4(sb <= lrow ? acc[n][0] : 0.f, sb + 1 <= lrow ? acc[n][1] : 0.f,
                                           sb + 2 <= lrow ? acc[n][2] : 0.f, sb + 3 <= lrow ? acc[n][3] : 0.f);
  }
  __syncthreads();
  f32x4 o[4];
#pragma unroll
  for (int n = 0; n < 4; ++n) o[n] = f32x4{0.f, 0.f, 0.f, 0.f};
  mma_strip_t<4, 2>(t3 + (w * 16) * 72, 72, t2, 72, o);
  mma_strip_t<4, 2>(t0 + (w * 16) * 72, 72, t4, 72, o);
  const float* nw = p.in[I_GLA_NW] + l * 256 + h * 64;
  float ss = 0.f;
#pragma unroll
  for (int n = 0; n < 4; ++n)
#pragma unroll
    for (int j = 0; j < 4; ++j) ss += o[n][j] * o[n][j];
  ss += __shfl_xor(ss, 16, 64);
  ss += __shfl_xor(ss, 32, 64);
  const float sc = rsqrtf(ss * (1.f / 64.f) + 1e-6f);
  const size_t tok = tok0 + lrow;
#pragma unroll
  for (int n = 0; n < 4; ++n) {
    const int v0 = n * 16 + fq * 4;
    uint2* gp = (uint2*)(P + tok * PC + h * 64 + v0);
    float g[4];
    unpack4(gq4[n], g);
    const float4 nv = *(const float4*)(nw + v0);
    if (!p.dry) *gp = pack4(o[n][0] * sc * nv.x * silu(g[0]), o[n][1] * sc * nv.y * silu(g[1]),
                            o[n][2] * sc * nv.z * silu(g[2]), o[n][3] * sc * nv.w * silu(g[3]));
  }
}

template <bool OUT>
__device__ __forceinline__ void ssd_item(const Params& p, int l, int b, int c, int h, unsigned char* smem) {
  u16* P = (u16*)(p.ws + OFF_P);
  const int tid = tidx(), lane = tid & 63, w = tid >> 6, fr = lane & 15, fq = lane >> 4;
  const int ch = lane, sq = w, g = h >> 1;
  u16* t0 = (u16*)smem;
  u16* t1 = t0 + 64 * 72;
  u16* t2 = t1 + 64 * 72;
  u16* t3 = t2 + 64 * 72;
  u16* t4 = t3 + 64 * 72;
  float* dts = (float*)(t4 + 64 * 72);
  float* acs = dts + 64;
  const size_t tok0 = (size_t)b * SEQ + c * 64;
  u16* sst = (u16*)(p.ws + OFF_SST) + ((size_t)((b * 128 + c) * 4 + h)) * 4096;
  __syncthreads();
  const int colx = C_XBC + h * 64 + ch, colb = C_XBC + 256 + g * 64 + ch, colc = C_XBC + 384 + g * 64 + ch;
  const int s0 = sq * 16;
  unsigned xr[19], br[19], cr[19];
#pragma unroll
  for (int j = 0; j < 19; ++j) {
    const int t = c * 64 + s0 - 3 + j;
    if (t >= 0) {
      const size_t tok = (size_t)b * SEQ + t;
      xr[j] = P[tok * PC + colx]; br[j] = P[tok * PC + colb]; cr[j] = P[tok * PC + colc];
    } else { xr[j] = 0u; br[j] = 0u; cr[j] = 0u; }
  }
  uint4 spv0 = make_uint4(0, 0, 0, 0), spv1 = spv0;
  uint2 gq4[4];
  if (OUT) {
    spv0 = *(const uint4*)(sst + tid * 8);
    spv1 = *(const uint4*)(sst + (tid + 256) * 8);
#pragma unroll
    for (int n = 0; n < 4; ++n) gq4[n] = *(const uint2*)(P + (tok0 + w * 16 + fr) * PC + 256 + h * 64 + n * 16 + fq * 4);
  }
  if (tid < 64) {
    float raw = bf2f(P[(tok0 + tid) * PC + C_DT + h]) + p.in[I_SSD_DTB][l * 4 + h];
    const float dtv = softplus(raw);
    dts[tid] = dtv;
    float x = dtv * -expf(p.in[I_SSD_ALOG][l * 4 + h]);
#pragma unroll
    for (int d = 1; d < 64; d <<= 1) {
      const float y = __shfl_up(x, d, 64);
      if (lane >= d) x += y;
    }
    acs[tid] = x;
  }
  __syncthreads();
  const float alast = acs[63];
  const int cix = h * 64 + ch, cib = 256 + g * 64 + ch, cic = 384 + g * 64 + ch;
  const float* cw = p.in[I_SSD_CW] + (size_t)l * 4 * 512;
  const float* cb = p.in[I_SSD_CB] + l * 512;
  float wx[4], wb[4], wcc[4];
#pragma unroll
  for (int j = 0; j < 4; ++j) { wx[j] = cw[j * 512 + cix]; wb[j] = cw[j * 512 + cib]; wcc[j] = cw[j * 512 + cic]; }
  const float bx = cb[cix], bb = cb[cib], bcv = cb[cic];
  float hx[3], hb[3], hc[3];
  unsigned pk0[8], pk1[8];
#pragma unroll
  for (int i = 0; i < 8; ++i) { pk0[i] = 0u; pk1[i] = 0u; }
#pragma unroll
  for (int j = 0; j < 3; ++j) { hx[j] = bf2f((u16)xr[j]); hb[j] = bf2f((u16)br[j]); hc[j] = bf2f((u16)cr[j]); }
#pragma unroll
  for (int i = 0; i < 16; ++i) {
    int s = s0 + i;
    float cx = bf2f((u16)xr[i + 3]), cbv = bf2f((u16)br[i + 3]), ccv = bf2f((u16)cr[i + 3]);
    float xs = silu(wx[0] * hx[0] + wx[1] * hx[1] + wx[2] * hx[2] + wx[3] * cx + bx);
    float bm = silu(wb[0] * hb[0] + wb[1] * hb[1] + wb[2] * hb[2] + wb[3] * cbv + bb);
    float cm = silu(wcc[0] * hc[0] + wcc[1] * hc[1] + wcc[2] * hc[2] + wcc[3] * ccv + bcv);
    hx[0] = hx[1]; hx[1] = hx[2]; hx[2] = cx;
    hb[0] = hb[1]; hb[1] = hb[2]; hb[2] = cbv;
    hc[0] = hc[1]; hc[1] = hc[2]; hc[2] = ccv;
    float dt = dts[s];
    if (OUT) {
      t0[s * 72 + ch] = f2bf(cm);
      t1[s * 72 + ch] = f2bf(bm);
      pk0[i >> 1] |= (unsigned)f2bf(xs * dt) << (16 * (i & 1));
      t4[s * 72 + ch] = f2bf(xs);
    } else {
      pk0[i >> 1] |= (unsigned)f2bf(bm) << (16 * (i & 1));
      pk1[i >> 1] |= (unsigned)f2bf(xs * dt * __expf(alast - acs[s])) << (16 * (i & 1));
    }
  }
  if (OUT) {
    *(uint4*)(t2 + ch * 72 + s0) = make_uint4(pk0[0], pk0[1], pk0[2], pk0[3]);
    *(uint4*)(t2 + ch * 72 + s0 + 8) = make_uint4(pk0[4], pk0[5], pk0[6], pk0[7]);
  } else {
    *(uint4*)(t0 + ch * 72 + s0) = make_uint4(pk0[0], pk0[1], pk0[2], pk0[3]);
    *(uint4*)(t0 + ch * 72 + s0 + 8) = make_uint4(pk0[4], pk0[5], pk0[6], pk0[7]);
    *(uint4*)(t1 + ch * 72 + s0) = make_uint4(pk1[0], pk1[1], pk1[2], pk1[3]);
    *(uint4*)(t1 + ch * 72 + s0 + 8) = make_uint4(pk1[4], pk1[5], pk1[6], pk1[7]);
  }
  if (!OUT) {
    if (!p.dry) { if (sq == 0) ((float*)(p.ws + OFF_SDC))[((size_t)((b * 128 + c) * 4 + h)) * 64 + ch] = __expf(alast); }
  } else {
    *(uint4*)(t3 + (tid >> 3) * 72 + (tid & 7) * 8) = spv0;
    *(uint4*)(t3 + ((tid + 256) >> 3) * 72 + (tid & 7) * 8) = spv1;
  }
  __syncthreads();
  f32x4 acc[4];
#pragma unroll
  for (int n = 0; n < 4; ++n) acc[n] = f32x4{0.f, 0.f, 0.f, 0.f};
  if (!OUT) {
    mma_strip_t<4, 2>(t1 + (w * 16) * 72, 72, t0, 72, acc);
    if (!p.dry) {
#pragma unroll
      for (int n = 0; n < 4; ++n)
        *(uint2*)(sst + (w * 16 + fr) * 64 + n * 16 + fq * 4) = pack4(acc[n][0], acc[n][1], acc[n][2], acc[n][3]);
    }
    return;
  }
  const int lrow = w * 16 + fr;
  mma_strip_t<4, 2>(t0 + (w * 16) * 72, 72, t1, 72, acc);
  __syncthreads();
  {
    const float al = acs[lrow];
#pragma unroll
    for (int n = 0; n < 4; ++n) {
      const int sb = n * 16 + fq * 4;
      float v[4];
#pragma unroll
      for (int j = 0; j < 4; ++j) v[j] = (sb + j <= lrow) ? acc[n][j] * __expf(al - acs[sb + j]) : 0.f;
      *(uint2*)(t1 + lrow * 72 + sb) = pack4(v[0], v[1], v[2], v[3]);
    }
  }
  __syncthreads();
  f32x4 y[4], yi[4];
#pragma unroll
  for (int n = 0; n < 4; ++n) { y[n] = f32x4{0.f, 0.f, 0.f, 0.f}; yi[n] = f32x4{0.f, 0.f, 0.f, 0.f}; }
  mma_strip_t<4, 2>(t1 + (w * 16) * 72, 72, t2, 72, y);
  mma_strip_t<4, 2>(t0 + (w * 16) * 72, 72, t3, 72, yi);
  const float Dh = p.in[I_SSD_D][l * 4 + h];
  const float* nw = p.in[I_SSD_NW] + l * 256 + h * 64;
  const float ea = __expf(acs[lrow]);
  float vals[4][4];
  float ss = 0.f;
#pragma unroll
  for (int n = 0; n < 4; ++n) {
    float xv[4];
    unpack4(*(const uint2*)(t4 + lrow * 72 + n * 16 + fq * 4), xv);
#pragma unroll
    for (int j = 0; j < 4; ++j) {
      float v = y[n][j] + yi[n][j] * ea + Dh * xv[j];
      vals[n][j] = v;
      ss += v * v;
    }
  }
  ss += __shfl_xor(ss, 16, 64);
  ss += __shfl_xor(ss, 32, 64);
  const float sc = rsqrtf(ss * (1.f / 64.f) + 1e-6f);
  const size_t tok = tok0 + lrow;
#pragma unroll
  for (int n = 0; n < 4; ++n) {
    const int p0 = n * 16 + fq * 4;
    uint2* gp = (uint2*)(P + tok * PC + 256 + h * 64 + p0);
    float g[4];
    unpack4(gq4[n], g);
    const float4 nv = *(const float4*)(nw + p0);
    if (!p.dry) *gp = pack4(vals[n][0] * sc * nv.x * silu(g[0]), vals[n][1] * sc * nv.y * silu(g[1]),
                            vals[n][2] * sc * nv.z * silu(g[2]), vals[n][3] * sc * nv.w * silu(g[3]));
  }
}

__device__ __forceinline__ void state_scan_item(const Params& p, u16* st, const float* dc, int item) {
  const int tid = tidx();
  const int bh = item >> 3, b = bh >> 2, h = bh & 3;
  const int e = ((item & 7) * 256 + tid) * 2;
  float s0 = 0.f, s1 = 0.f;
#pragma unroll 1
  for (int c0 = 0; c0 < 128; c0 += 8) {
    unsigned cv[8];
    float2 dv[8];
#pragma unroll
    for (int i = 0; i < 8; ++i) {
      size_t base = (size_t)((b * 128 + c0 + i) * 4 + h);
      cv[i] = *(const unsigned*)(st + base * 4096 + e);
      dv[i] = *(const float2*)(dc + base * 64 + (e & 63));
    }
#pragma unroll
    for (int i = 0; i < 8; ++i) {
      size_t base = (size_t)((b * 128 + c0 + i) * 4 + h);
      if (!p.dry) { *(unsigned*)(st + base * 4096 + e) = (unsigned)f2bf(s0) | ((unsigned)f2bf(s1) << 16); }
      s0 = dv[i].x * s0 + __uint_as_float(cv[i] << 16);
      s1 = dv[i].y * s1 + __uint_as_float(cv[i] & 0xffff0000u);
    }
  }
}

template <bool OUT>
__device__ __forceinline__ void s5_item(const Params& p, int l, int b, int c, unsigned char* smem) {
  u16* P = (u16*)(p.ws + OFF_P);
  const int tid = tidx(), lane = tid & 63, w = tid >> 6, fr = lane & 15, fq = lane >> 4;
  float* Bu = (float*)smem + w * (16 * 132);
  const size_t tok0 = (size_t)b * SEQ + c * 64;
  __syncthreads();
  for (int gi = 0; gi < 4; ++gi) {
    const int g = gi * 4 + w;
    const float* Ab = (const float*)(p.ws + OFF_S5A) + ((size_t)(l * 16 + g) * 64) * 2;
    const u16* Bb = (const u16*)(p.ws + OFF_S5B) + (size_t)(l * 16 + g) * 128 * 32;
    const u16* Cm = (const u16*)(p.ws + OFF_S5C) + (size_t)(l * 16 + g) * 16 * 128;
    float* xs = (float*)(p.ws + OFF_S5X) + (((size_t)(b * 128 + c) * 16 + g) * 64) * 2;
    const float ar = Ab[lane * 2], ai = Ab[lane * 2 + 1];
    float xr = 0.f, xi = 0.f;
    if (OUT) { xr = xs[lane * 2]; xi = xs[lane * 2 + 1]; }
    const float Dv = p.in[I_S5_D][l * 256 + g * 16 + fr];
    for (int mt = 0; mt < 4; ++mt) {
      bf16x8 a = bf16x8{0, 0, 0, 0, 0, 0, 0, 0};
      if (fq < 2) a = *(const bf16x8*)(P + (tok0 + mt * 16 + fr) * PC + C_S5U + g * 16 + fq * 8);
#pragma unroll
      for (int nt = 0; nt < 8; ++nt) {
        bf16x8 bb = *(const bf16x8*)(Bb + (nt * 16 + fr) * 32 + fq * 8);
        f32x4 r = __builtin_amdgcn_mfma_f32_16x16x32_bf16(a, bb, f32x4{0.f, 0.f, 0.f, 0.f}, 0, 0, 0);
#pragma unroll
        for (int j = 0; j < 4; ++j) Bu[(fq * 4 + j) * 132 + nt * 16 + fr] = r[j];
      }
      __syncthreads();
      for (int t = 0; t < 16; ++t) {
        float bre = Bu[t * 132 + lane], bim = Bu[t * 132 + 64 + lane];
        float nr = ar * xr - ai * xi + bre;
        float ni = ar * xi + ai * xr + bim;
        xr = nr; xi = ni;
        if (OUT) {
          u16* X = (u16*)(Bu + t * 132);
          X[lane] = f2bf(xr);
          X[64 + lane] = f2bf(xi);
        }
      }
      __syncthreads();
      if (OUT) {
        f32x4 ya[1];
        ya[0] = f32x4{0.f, 0.f, 0.f, 0.f};
        mma_strip<1, 4>((const u16*)Bu, 264, Cm, 128, ya);
#pragma unroll
        for (int j = 0; j < 4; ++j) {
          size_t a_ = (tok0 + mt * 16 + fq * 4 + j) * PC + C_S5U + g * 16 + fr;
          float uval = bf2f(P[a_]);
          float yv = ya[0][j] + Dv * uval;
          if (!p.dry) { P[a_] = f2bf(gelu_tanh(yv)); }
        }
        __syncthreads();
      }
    }
    if (!p.dry) { if (!OUT) { xs[lane * 2] = xr; xs[lane * 2 + 1] = xi; } }
  }
}

__device__ __forceinline__ void s5_scan_item(const Params& p, int l, int item) {
  const int sidx = item * 256 + tidx();
  const int b = sidx >> 10, gp = sidx & 1023;
  const float* A64 = (const float*)(p.ws + OFF_S5A64) + ((size_t)l * 1024 + gp) * 2;
  const float ar = A64[0], ai = A64[1];
  float2* xs = (float2*)(p.ws + OFF_S5X);
  float xr = 0.f, xi = 0.f;
#pragma unroll 1
  for (int c0 = 0; c0 < 128; c0 += 8) {
    float2 v[8];
#pragma unroll
    for (int i = 0; i < 8; ++i) v[i] = xs[(size_t)(b * 128 + c0 + i) * 1024 + gp];
#pragma unroll
    for (int i = 0; i < 8; ++i) {
      if (!p.dry) { xs[(size_t)(b * 128 + c0 + i) * 1024 + gp] = make_float2(xr, xi); }
      float nr = ar * xr - ai * xi + v[i].x;
      float ni = ar * xi + ai * xr + v[i].y;
      xr = nr; xi = ni;
    }
  }
}

__device__ __forceinline__ void rwkv_prep_item(const Params& p, int l, int item, unsigned char* smem) {
  u16* P = (u16*)(p.ws + OFF_P);
  const int tid = tidx(), lane = tid & 63, w = tid >> 6, fr = lane & 15, fq = lane >> 4;
  u16* Aw = (u16*)smem;
  u16* Aa = Aw + 16 * 72;
  u16* Av = Aa + 16 * 72;
  u16* Awl = Av + 16 * 40;
  const size_t tok0 = (size_t)item * 16;
  const float* mu = p.in[I_RW_MU] + l * 896;
  __syncthreads();
  for (int idx = tid; idx < 160 * 16; idx += 256) {
    int t = idx / 160, j = idx % 160;
    size_t tok = tok0 + t;
    if (j < 128) {
      int col = C_RW + 768 + j;
      float cur = bf2f(P[tok * PC + col]);
      float prev = ((tok & (SEQ - 1)) != 0) ? bf2f(P[(tok - 1) * PC + col]) : 0.f;
      float val = cur + (prev - cur) * mu[768 + j];
      if (j < 64) {
        const float th = 1.f - 2.f / (1.f + __expf(2.f * val));
        const u16 hi = f2bf(th);
        Aw[t * 72 + j] = hi;
        Awl[t * 72 + j] = f2bf(th - bf2f(hi));
      }
      else Aa[t * 72 + j - 64] = f2bf(val);
    } else {
      Av[t * 40 + j - 128] = P[tok * PC + C_VL + j - 128];
    }
  }
  __syncthreads();
  f32x4 accw[4], acca[4], accv[4];
#pragma unroll
  for (int n = 0; n < 4; ++n) { accw[n] = f32x4{0.f, 0.f, 0.f, 0.f}; acca[n] = accw[n]; accv[n] = accw[n]; }
  mma_strip_t<4, 2>(Aw, 72, (const u16*)(p.ws + OFF_W2T) + ((size_t)l * 256 + w * 64) * 64, 64, accw);
  mma_strip_t<4, 2>(Awl, 72, (const u16*)(p.ws + OFF_W2T) + ((size_t)l * 256 + w * 64) * 64, 64, accw);
  mma_strip_t<4, 2>(Aw, 72, (const u16*)(p.ws + OFF_W2L) + ((size_t)l * 256 + w * 64) * 64, 64, accw);
  mma_strip_t<4, 2>(Aa, 72, (const u16*)(p.ws + OFF_A2T) + ((size_t)l * 256 + w * 64) * 64, 64, acca);
  if (l > 0) mma_strip_t<4, 1>(Av, 40, (const u16*)(p.ws + OFF_V2T) + ((size_t)(l - 1) * 256 + w * 64) * 32, 32, accv);
  u16* R = (u16*)(p.ws + OFF_PREP);
  u16* Kp = R + (size_t)NTOK * 256;
  u16* V = Kp + (size_t)NTOK * 256;
  u16* KK = V + (size_t)NTOK * 256;
  u16* BV = KK + (size_t)NTOK * 256;
  u16* LW = BV + (size_t)NTOK * 256;
  u16* VF = (u16*)(p.ws + OFF_VF);
  const size_t tok = tok0 + fr;
  const bool hasprev = (tok & (SEQ - 1)) != 0;
  float kkv[4][4], av[4][4], kx[4][4];
  float ss = 0.f;
#pragma unroll
  for (int n = 0; n < 4; ++n) {
    const int cb = w * 64 + n * 16 + fq * 4;
    float kc_[4], kp_[4] = {0.f, 0.f, 0.f, 0.f};
    unpack4(*(const uint2*)(P + tok * PC + C_RW + 256 + cb), kc_);
    if (hasprev) unpack4(*(const uint2*)(P + (tok - 1) * PC + C_RW + 256 + cb), kp_);
    const float4 muk = *(const float4*)(mu + 256 + cb);
    const float4 kkw = *(const float4*)(p.in[I_RW_KK] + l * 256 + cb);
    const float4 a0 = *(const float4*)(p.in[I_RW_A0] + l * 256 + cb);
    const float mk[4] = {muk.x, muk.y, muk.z, muk.w}, kw[4] = {kkw.x, kkw.y, kkw.z, kkw.w}, a0v[4] = {a0.x, a0.y, a0.z, a0.w};
#pragma unroll
    for (int j = 0; j < 4; ++j) {
      const float k = kc_[j] + (kp_[j] - kc_[j]) * mk[j];
      kx[n][j] = k;
      const float kk = k * kw[j];
      kkv[n][j] = kk;
      ss += kk * kk;
      av[n][j] = sigm(a0v[j] + acca[n][j]);
    }
  }
  ss += __shfl_xor(ss, 16, 64);
  ss += __shfl_xor(ss, 32, 64);
  const float kn = rsqrtf(ss + 1e-12f);
#pragma unroll
  for (int n = 0; n < 4; ++n) {
    const int cb = w * 64 + n * 16 + fq * 4;
    float rc[4], rp[4] = {0.f, 0.f, 0.f, 0.f}, vc[4], vp[4] = {0.f, 0.f, 0.f, 0.f};
    unpack4(*(const uint2*)(P + tok * PC + C_RW + cb), rc);
    unpack4(*(const uint2*)(P + tok * PC + C_RW + 512 + cb), vc);
    if (hasprev) {
      unpack4(*(const uint2*)(P + (tok - 1) * PC + C_RW + cb), rp);
      unpack4(*(const uint2*)(P + (tok - 1) * PC + C_RW + 512 + cb), vp);
    }
    const float4 mur = *(const float4*)(mu + cb);
    const float4 muv = *(const float4*)(mu + 512 + cb);
    const float4 w0 = *(const float4*)(p.in[I_RW_W0] + l * 256 + cb);
    const float4 kaw = *(const float4*)(p.in[I_RW_KA] + l * 256 + cb);
    const float mr[4] = {mur.x, mur.y, mur.z, mur.w}, mv[4] = {muv.x, muv.y, muv.z, muv.w};
    const float w0v[4] = {w0.x, w0.y, w0.z, w0.w}, kav[4] = {kaw.x, kaw.y, kaw.z, kaw.w};
    float vfv[4] = {0.f, 0.f, 0.f, 0.f}, v0v[4] = {0.f, 0.f, 0.f, 0.f};
    if (l > 0) {
      unpack4(*(const uint2*)(VF + tok * 256 + cb), vfv);
      const float4 v0 = *(const float4*)(p.in[I_RW_V0] + (l - 1) * 256 + cb);
      v0v[0] = v0.x; v0v[1] = v0.y; v0v[2] = v0.z; v0v[3] = v0.w;
    }
    float ro[4], ko[4], vo[4], kko[4], bo[4], lo[4];
#pragma unroll
    for (int j = 0; j < 4; ++j) {
      ro[j] = rc[j] + (rp[j] - rc[j]) * mr[j];
      float v = vc[j] + (vp[j] - vc[j]) * mv[j];
      if (l > 0) v = v + (vfv[j] - v) * sigm(v0v[j] + accv[n][j]);
      vo[j] = v;
      const float wraw = -softplus(-(w0v[j] + accw[n][j])) - 0.5f;
      lo[j] = -__expf(wraw);
      const float a = av[n][j];
      const float kk = kkv[n][j] * kn;
      kko[j] = kk;
      bo[j] = kk * a;
      ko[j] = kx[n][j] * (1.f + (a - 1.f) * kav[j]);
    }
    if (!p.dry) {
      const size_t o = tok * 256 + cb;
      if (l == 0) *(uint2*)(VF + o) = pack4(vo[0], vo[1], vo[2], vo[3]);
      *(uint2*)(R + o) = pack4(ro[0], ro[1], ro[2], ro[3]);
      *(uint2*)(Kp + o) = pack4(ko[0], ko[1], ko[2], ko[3]);
      *(uint2*)(V + o) = pack4(vo[0], vo[1], vo[2], vo[3]);
      *(uint2*)(KK + o) = pack4(kko[0], kko[1], kko[2], kko[3]);
      *(uint2*)(BV + o) = pack4(bo[0], bo[1], bo[2], bo[3]);
      *(uint2*)(LW + o) = pack4(lo[0], lo[1], lo[2], lo[3]);
    }
  }
}

typedef float f2 __attribute__((ext_vector_type(2)));
__device__ __forceinline__ float dpp_xor1(float v) { return __int_as_float(__builtin_amdgcn_update_dpp(0, __float_as_int(v), 0xB1, 0xf, 0xf, false)); }
__device__ __forceinline__ float dpp_xor2(float v) { return __int_as_float(__builtin_amdgcn_update_dpp(0, __float_as_int(v), 0x4E, 0xf, 0xf, false)); }
__device__ __forceinline__ void unpack8(const uint4& u, float* o) {
  o[0] = __uint_as_float(u.x << 16); o[1] = __uint_as_float(u.x & 0xffff0000u);
  o[2] = __uint_as_float(u.y << 16); o[3] = __uint_as_float(u.y & 0xffff0000u);
  o[4] = __uint_as_float(u.z << 16); o[5] = __uint_as_float(u.z & 0xffff0000u);
  o[6] = __uint_as_float(u.w << 16); o[7] = __uint_as_float(u.w & 0xffff0000u);
}
__device__ __forceinline__ void stage8(float* dst, const uint4& u, bool do_exp) {
  float o[8];
  unpack8(u, o);
  if (do_exp) {
#pragma unroll
    for (int i = 0; i < 8; ++i) o[i] = __expf(o[i]);
  }
  ((float4*)dst)[0] = make_float4(o[0], o[1], o[2], o[3]);
  ((float4*)dst)[1] = make_float4(o[4], o[5], o[6], o[7]);
}
template <int PASS>
__device__ __forceinline__ void rwkv_scan_wave(const Params& p, int l, int wi, float* lds) {
  u16* P = (u16*)(p.ws + OFF_P);
  const int lane = tidx() & 63, rg = lane >> 2, q = lane & 3;
  int which = 0, seg, bh;
  if (PASS == 1) { which = wi & 1; seg = (wi >> 1) % NSEG; bh = (wi >> 1) / NSEG; }
  else { seg = wi % NSEG; bh = wi / NSEG; }
  const int b = bh >> 2, h = bh & 3;
  float* sw = lds;
  float* skk = sw + 512;
  float* sb = skk + 512;
  float* sk = sb + 512;
  float* sv = sk + 512;
  float* sr = sv + 512;
  float* sy = sw;
  const u16* R = (const u16*)(p.ws + OFF_PREP);
  const u16* Kp = R + (size_t)NTOK * 256;
  const u16* V = Kp + (size_t)NTOK * 256;
  const u16* KK = V + (size_t)NTOK * 256;
  const u16* BV = KK + (size_t)NTOK * 256;
  const u16* LW = BV + (size_t)NTOK * 256;
  float* Sl = (float*)(p.ws + OFF_RSL) + ((size_t)(bh * NSEG + seg)) * 4096;
  float* Pm = (float*)(p.ws + OFF_RPM) + ((size_t)(bh * NSEG + seg)) * 4096;
  f2 e[4][8];
  if (PASS == 1) {
#pragma unroll
    for (int r = 0; r < 4; ++r)
#pragma unroll
      for (int j = 0; j < 8; ++j) {
        int row = rg * 4 + r, c0 = q * 16 + j * 2;
        e[r][j] = f2{(which == 1 && row == c0) ? 1.f : 0.f, (which == 1 && row == c0 + 1) ? 1.f : 0.f};
      }
  } else {
#pragma unroll
    for (int r = 0; r < 4; ++r)
#pragma unroll
      for (int i = 0; i < 4; ++i) {
        float4 v = *(const float4*)(Sl + (rg * 4 + r) * 64 + q * 16 + i * 4);
        e[r][i * 2] = f2{v.x, v.y};
        e[r][i * 2 + 1] = f2{v.z, v.w};
      }
  }
  const bool usev = !(PASS == 1 && which == 1);
  const int st = lane >> 3, sc8 = (lane & 7) * 8;
  const size_t g0 = ((size_t)b * SEQ + (size_t)seg * SEGLEN) * 256 + h * 64 + (size_t)st * 256 + sc8;
  float rkw[8], gnw[8], gnb[8];
  if (PASS == 3) {
#pragma unroll
    for (int i = 0; i < 8; ++i) {
      rkw[i] = p.in[I_RW_RK][l * 256 + h * 64 + sc8 + i];
      gnw[i] = p.in[I_RW_GNW][l * 256 + h * 64 + sc8 + i];
      gnb[i] = p.in[I_RW_GNB][l * 256 + h * 64 + sc8 + i];
    }
  }
  uint4 nlw, nkk, nb, nk, nv, nr;
  nv = make_uint4(0, 0, 0, 0);
  nr = nv;
#define RW_ISSUE(sc)                                              \
  {                                                               \
    const size_t gi = g0 + (size_t)(sc) * 8 * 256;                \
    nlw = *(const uint4*)(LW + gi);                               \
    nkk = *(const uint4*)(KK + gi);                               \
    nb = *(const uint4*)(BV + gi);                                \
    nk = *(const uint4*)(Kp + gi);                                \
    if (usev) nv = *(const uint4*)(V + gi);                       \
    if (PASS == 3) nr = *(const uint4*)(R + gi);                  \
  }
  RW_ISSUE(0);
#pragma unroll 1
  for (int sc = 0; sc < SEGLEN / 8; ++sc) {
    asm volatile("" ::: "memory");
    stage8(sw + st * 64 + sc8, nlw, true);
    stage8(skk + st * 64 + sc8, nkk, false);
    stage8(sb + st * 64 + sc8, nb, false);
    stage8(sk + st * 64 + sc8, nk, false);
    stage8(sv + st * 64 + sc8, nv, false);
    if (PASS == 3) stage8(sr + st * 64 + sc8, nr, false);
    if (sc + 1 < SEGLEN / 8) RW_ISSUE(sc + 1);
    __builtin_amdgcn_wave_barrier();
    asm volatile("" ::: "memory");
#pragma unroll 2
    for (int t = 0; t < 8; ++t) {
      f2 kk2[8], w2[8], b2[8], k2[8];
#pragma unroll
      for (int i = 0; i < 4; ++i) {
        float4 a = ((const float4*)(skk + t * 64 + q * 16))[i];
        kk2[i * 2] = f2{a.x, a.y}; kk2[i * 2 + 1] = f2{a.z, a.w};
        float4 c = ((const float4*)(sw + t * 64 + q * 16))[i];
        w2[i * 2] = f2{c.x, c.y}; w2[i * 2 + 1] = f2{c.z, c.w};
        float4 d = ((const float4*)(sb + t * 64 + q * 16))[i];
        b2[i * 2] = f2{d.x, d.y}; b2[i * 2 + 1] = f2{d.z, d.w};
        float4 g = ((const float4*)(sk + t * 64 + q * 16))[i];
        k2[i * 2] = f2{g.x, g.y}; k2[i * 2 + 1] = f2{g.z, g.w};
      }
      const float4 vv4 = *(const float4*)(sv + t * 64 + rg * 4);
      const float vvr[4] = {vv4.x, vv4.y, vv4.z, vv4.w};
      float sa[4];
#pragma unroll
      for (int r = 0; r < 4; ++r) {
        f2 acc = e[r][0] * kk2[0];
#pragma unroll
        for (int j = 1; j < 8; ++j) acc = e[r][j] * kk2[j] + acc;
        float part = acc.x + acc.y;
        part += dpp_xor1(part);
        part += dpp_xor2(part);
        sa[r] = -part;
      }
#pragma unroll
      for (int r = 0; r < 4; ++r) {
        const f2 sa2 = f2{sa[r], sa[r]};
        const f2 vv2 = f2{vvr[r], vvr[r]};
#pragma unroll
        for (int j = 0; j < 8; ++j) {
          f2 tnew = e[r][j] * w2[j];
          tnew = sa2 * b2[j] + tnew;
          tnew = vv2 * k2[j] + tnew;
          e[r][j] = tnew;
        }
      }
      if (PASS == 3) {
        f2 r2[8];
#pragma unroll
        for (int i = 0; i < 4; ++i) {
          float4 a = ((const float4*)(sr + t * 64 + q * 16))[i];
          r2[i * 2] = f2{a.x, a.y}; r2[i * 2 + 1] = f2{a.z, a.w};
        }
        float yv[4];
#pragma unroll
        for (int r = 0; r < 4; ++r) {
          f2 acc = e[r][0] * r2[0];
#pragma unroll
          for (int j = 1; j < 8; ++j) acc = e[r][j] * r2[j] + acc;
          float part = acc.x + acc.y;
          part += dpp_xor1(part);
          part += dpp_xor2(part);
          yv[r] = part;
        }
        if (q == 0) *(float4*)(sy + t * 64 + rg * 4) = make_float4(yv[0], yv[1], yv[2], yv[3]);
      }
    }
    if (PASS == 3) {
      __builtin_amdgcn_wave_barrier();
      asm volatile("" ::: "memory");
      float yv[8], rr[8], kx[8], vx[8];
#pragma unroll
      for (int i = 0; i < 2; ++i) {
        float4 a = ((const float4*)(sy + st * 64 + sc8))[i];
        yv[i * 4] = a.x; yv[i * 4 + 1] = a.y; yv[i * 4 + 2] = a.z; yv[i * 4 + 3] = a.w;
        float4 c = ((const float4*)(sr + st * 64 + sc8))[i];
        rr[i * 4] = c.x; rr[i * 4 + 1] = c.y; rr[i * 4 + 2] = c.z; rr[i * 4 + 3] = c.w;
        float4 d = ((const float4*)(sk + st * 64 + sc8))[i];
        kx[i * 4] = d.x; kx[i * 4 + 1] = d.y; kx[i * 4 + 2] = d.z; kx[i * 4 + 3] = d.w;
        float4 g = ((const float4*)(sv + st * 64 + sc8))[i];
        vx[i * 4] = g.x; vx[i * 4 + 1] = g.y; vx[i * 4 + 2] = g.z; vx[i * 4 + 3] = g.w;
      }
      float s1 = 0.f, bon = 0.f;
#pragma unroll
      for (int i = 0; i < 8; ++i) { s1 += yv[i]; bon += rr[i] * kx[i] * rkw[i]; }
#pragma unroll
      for (int m = 4; m >= 1; m >>= 1) { s1 += __shfl_xor(s1, m, 64); bon += __shfl_xor(bon, m, 64); }
      const float mean = s1 * (1.f / 64.f);
      float s2 = 0.f;
#pragma unroll
      for (int i = 0; i < 8; ++i) { float d = yv[i] - mean; s2 += d * d; }
#pragma unroll
      for (int m = 4; m >= 1; m >>= 1) s2 += __shfl_xor(s2, m, 64);
      const float rs = rsqrtf(s2 * (1.f / 64.f) + 64e-5f);
      const size_t tok = (size_t)b * SEQ + (size_t)seg * SEGLEN + sc * 8 + st;
      uint4* gp = (uint4*)(P + tok * PC + 768 + h * 64 + sc8);
      uint4 gq = *gp;
      float gt[8];
      unpack8(gq, gt);
      unsigned ow[4];
#pragma unroll
      for (int i = 0; i < 4; ++i) {
        float o0 = ((yv[2 * i] - mean) * rs * gnw[2 * i] + gnb[2 * i] + bon * vx[2 * i]) * silu(gt[2 * i]);
        float o1 = ((yv[2 * i + 1] - mean) * rs * gnw[2 * i + 1] + gnb[2 * i + 1] + bon * vx[2 * i + 1]) * silu(gt[2 * i + 1]);
        ow[i] = (unsigned)f2bf(o0) | ((unsigned)f2bf(o1) << 16);
      }
      if (!p.dry) *gp = make_uint4(ow[0], ow[1], ow[2], ow[3]);
    }
  }
#undef RW_ISSUE
  if (PASS == 1) {
    float* dst = (which == 0) ? Sl : Pm;
    if (!p.dry) {
#pragma unroll
      for (int r = 0; r < 4; ++r)
#pragma unroll
        for (int i = 0; i < 4; ++i)
          *(float4*)(dst + (rg * 4 + r) * 64 + q * 16 + i * 4) = make_float4(e[r][i * 2].x, e[r][i * 2].y, e[r][i * 2 + 1].x, e[r][i * 2 + 1].y);
    }
  }
}

__device__ __forceinline__ void rwkv_chain_item(const Params& p, int item, unsigned char* smem) {
  const int tid = tidx();
  const int bh = item >> 2, rg = item & 3;
  const int lr = tid >> 4, row = rg * 16 + lr, cq = tid & 15;
  float* srow = (float*)smem;
  float* sP = srow + 1024;
  float* SlB = (float*)(p.ws + OFF_RSL) + ((size_t)(bh * NSEG)) * 4096;
  const float* PmB = (const float*)(p.ws + OFF_RPM) + ((size_t)(bh * NSEG)) * 4096;
  float4 cur = make_float4(0.f, 0.f, 0.f, 0.f);
  float4 a0, a1, a2, a3, al, b0, b1, b2, b3, bl, c0, c1, c2, c3, cl, d0, d1, d2, d3, dl;
#define CH_LOAD(X, sg)                                                         \
  {                                                                            \
    const float4* nP = (const float4*)(PmB + (size_t)(sg) * 4096);             \
    X##0 = nP[tid]; X##1 = nP[tid + 256]; X##2 = nP[tid + 512]; X##3 = nP[tid + 768]; \
    X##l = *(const float4*)(SlB + (size_t)(sg) * 4096 + row * 64 + cq * 4);    \
  }
#define CH_STEP(X, Y, sg)                                                      \
  {                                                                            \
    ((float4*)sP)[tid] = X##0; ((float4*)sP)[tid + 256] = X##1;                \
    ((float4*)sP)[tid + 512] = X##2; ((float4*)sP)[tid + 768] = X##3;          \
    *(float4*)(srow + lr * 64 + cq * 4) = cur;                                 \
    float4 nx = X##l;                                                          \
    __syncthreads();                                                           \
    if (!p.dry) { *(float4*)(SlB + (size_t)(sg) * 4096 + row * 64 + cq * 4) = cur; } \
    if ((sg) + 3 < NSEG) CH_LOAD(Y, (sg) + 3);                                 \
    _Pragma("unroll 16") for (int j = 0; j < 64; ++j) {                        \
      float sv_ = srow[lr * 64 + j];                                           \
      float4 pm = *(const float4*)(sP + j * 64 + cq * 4);                      \
      nx.x += sv_ * pm.x; nx.y += sv_ * pm.y; nx.z += sv_ * pm.z; nx.w += sv_ * pm.w; \
    }                                                                          \
    __syncthreads();                                                           \
    cur = nx;                                                                  \
  }
  CH_LOAD(a, 0);
  CH_LOAD(b, 1);
  CH_LOAD(c, 2);
  d0 = d1 = d2 = d3 = dl = cur;
  __syncthreads();
#pragma unroll 1
  for (int seg = 0; seg < NSEG; seg += 4) {
    CH_STEP(a, d, seg);
    CH_STEP(b, a, seg + 1);
    CH_STEP(c, b, seg + 2);
    CH_STEP(d, c, seg + 3);
  }
#undef CH_LOAD
#undef CH_STEP
}

__device__ __forceinline__ void memattn_item(const Params& p, int l, int b, int h, int tile, unsigned char* smem) {
  u16* P = (u16*)(p.ws + OFF_P);
  const int tid = tidx(), lane = tid & 63, w = tid >> 6, fr = lane & 15, fq = lane >> 4;
  u16* pw = (u16*)smem + w * (16 * 264);
  const u16* km = (const u16*)(p.ws + OFF_KM) + (size_t)l * 1024 * 256 + (size_t)b * 256 * 256 + h * 64;
  const u16* vmT = (const u16*)(p.ws + OFF_VMT) + (size_t)l * 4 * 256 * 256 + ((size_t)b * 256 + h * 64) * 256;
  const size_t tok0 = (size_t)b * SEQ + tile * 64 + w * 16;
  __syncthreads();
  f32x4 acc[16];
#pragma unroll
  for (int n = 0; n < 16; ++n) acc[n] = f32x4{0.f, 0.f, 0.f, 0.f};
  {
    const u16* Aq = P + tok0 * PC + C_MQ + h * 64;
    bf16x8 a0 = *(const bf16x8*)(Aq + fr * PC + fq * 8);
    bf16x8 a1 = *(const bf16x8*)(Aq + fr * PC + 32 + fq * 8);
#pragma unroll
    for (int n4 = 0; n4 < 4; ++n4) {
#pragma unroll
      for (int nn = 0; nn < 4; ++nn) {
        int n = n4 * 4 + nn;
        bf16x8 b0 = *(const bf16x8*)(km + (n * 16 + fr) * 256 + fq * 8);
        bf16x8 b1 = *(const bf16x8*)(km + (n * 16 + fr) * 256 + 32 + fq * 8);
        acc[n] = __builtin_amdgcn_mfma_f32_16x16x32_bf16(b0, a0, acc[n], 0, 0, 0);
        acc[n] = __builtin_amdgcn_mfma_f32_16x16x32_bf16(b1, a1, acc[n], 0, 0, 0);
      }
      __builtin_amdgcn_sched_barrier(0);
    }
  }
  {
    float mx = -1e30f;
#pragma unroll
    for (int n = 0; n < 16; ++n)
#pragma unroll
      for (int j = 0; j < 4; ++j) mx = fmaxf(mx, acc[n][j]);
    mx = fmaxf(mx, __shfl_xor(mx, 16, 64));
    mx = fmaxf(mx, __shfl_xor(mx, 32, 64));
    float sm = 0.f;
#pragma unroll
    for (int n = 0; n < 16; ++n)
#pragma unroll
      for (int j = 0; j < 4; ++j) { float ev = __expf((acc[n][j] - mx) * 0.125f); acc[n][j] = ev; sm += ev; }
    sm += __shfl_xor(sm, 16, 64);
    sm += __shfl_xor(sm, 32, 64);
    const float inv = 1.f / sm;
#pragma unroll
    for (int n = 0; n < 16; ++n)
      *(uint2*)(pw + fr * 264 + n * 16 + fq * 4) = pack4(acc[n][0] * inv, acc[n][1] * inv, acc[n][2] * inv, acc[n][3] * inv);
  }
  __syncthreads();
  f32x4 o[4];
#pragma unroll
  for (int n = 0; n < 4; ++n) o[n] = f32x4{0.f, 0.f, 0.f, 0.f};
  mma_strip_t<4, 8>(pw, 264, vmT, 256, o);
#pragma unroll
  for (int n = 0; n < 4; ++n) {
    uint2* gp = (uint2*)(P + (tok0 + fr) * PC + 1024 + h * 64 + n * 16 + fq * 4);
    float g[4];
    unpack4(*gp, g);
    if (!p.dry) *gp = pack4(o[n][0] * silu(g[0]), o[n][1] * silu(g[1]), o[n][2] * silu(g[2]), o[n][3] * silu(g[3]));
  }
}

__device__ __forceinline__ void ln_item(const Params& p, int l, int item) {
  const int lane = tidx() & 63, w = tidx() >> 6;
  const size_t row = (size_t)item * 4 + w;
  float4* x = (float4*)(p.out + row * 1024);
  float4 v[4];
  float s = 0.f;
#pragma unroll
  for (int i = 0; i < 4; ++i) { v[i] = x[lane + 64 * i]; s += v[i].x + v[i].y + v[i].z + v[i].w; }
  s = wave_sum(s);
  const float mean = s * (1.f / 1024.f);
  float s2 = 0.f;
#pragma unroll
  for (int i = 0; i < 4; ++i) {
    float a = v[i].x - mean, b = v[i].y - mean, c = v[i].z - mean, d = v[i].w - mean;
    s2 += a * a + b * b + c * c + d * d;
  }
  s2 = wave_sum(s2);
  const float rs = rsqrtf(s2 * (1.f / 1024.f) + 1e-5f);
  const float4* lw = (const float4*)(p.in[I_LNW] + l * 1024);
  const float4* lb = (const float4*)(p.in[I_LNB] + l * 1024);
#pragma unroll
  for (int i = 0; i < 4; ++i) {
    float4 wv = lw[lane + 64 * i], bv = lb[lane + 64 * i], o;
    o.x = (v[i].x - mean) * rs * wv.x + bv.x;
    o.y = (v[i].y - mean) * rs * wv.y + bv.y;
    o.z = (v[i].z - mean) * rs * wv.z + bv.z;
    o.w = (v[i].w - mean) * rs * wv.w + bv.w;
    if (!p.dry) {
      x[lane + 64 * i] = o;
      if (l + 1 < NL) {
        uint2 ov;
        ov.x = (unsigned)f2bf(o.x) | ((unsigned)f2bf(o.y) << 16);
        ov.y = (unsigned)f2bf(o.z) | ((unsigned)f2bf(o.w) << 16);
        ((uint2*)((u16*)(p.ws + OFF_PREP) + row * 1024))[lane + 64 * i] = ov;
      }
    }
  }
}

__device__ __forceinline__ unsigned touch_gla(const Params& p, int tn, bool out) {
  if (tn >= 2048) return 0u;
  const u16* P = (const u16*)(p.ws + OFF_P);
  const int tid = tidx(), s = tid & 63, wq = tid >> 6;
  const int b = tn >> 9, c = (tn >> 2) & 127, h = tn & 3;
  const size_t tok0 = (size_t)b * SEQ + c * 64;
  const int col = (wq == 0 ? C_GQ : wq == 1 ? C_GK : wq == 2 ? C_GV : C_GA) + (wq < 3 ? h * 64 : 0);
  unsigned r = *(const unsigned*)(P + (tok0 + s) * PC + col);
  if (out) {
    if (tid < 64) r ^= *(const unsigned*)((const u16*)(p.ws + OFF_GST) + ((size_t)((b * 128 + c) * 4 + h)) * 4096 + tid * 64);
    else if (tid >= 128 && tid < 192) r ^= *(const unsigned*)(P + (tok0 + tid - 128) * PC + h * 64);
  }
  return r;
}
__device__ __forceinline__ unsigned touch_ssd(const Params& p, int tn, bool out) {
  if (tn >= 2048) return 0u;
  const u16* P = (const u16*)(p.ws + OFF_P);
  const int tid = tidx(), s = tid & 63, wq = tid >> 6;
  const int b = tn >> 9, c = (tn >> 2) & 127, h = tn & 3, g = h >> 1;
  const size_t tok0 = (size_t)b * SEQ + c * 64;
  const int col = wq == 0 ? C_XBC + h * 64 : wq == 1 ? C_XBC + 256 + g * 64 : wq == 2 ? C_XBC + 384 + g * 64 : C_DT;
  unsigned r = *(const unsigned*)(P + (tok0 + s) * PC + col);
  if (out) {
    if (tid < 64) r ^= *(const unsigned*)((const u16*)(p.ws + OFF_SST) + ((size_t)((b * 128 + c) * 4 + h)) * 4096 + tid * 64);
    else if (tid >= 128 && tid < 192) r ^= *(const unsigned*)(P + (tok0 + tid - 128) * PC + 256 + h * 64);
  }
  return r;
}
__device__ __forceinline__ unsigned touch_s5(const Params& p, int tn) {
  if (tn >= 512) return 0u;
  const u16* P = (const u16*)(p.ws + OFF_P);
  const int tid = tidx();
  const size_t tok0 = (size_t)(tn >> 7) * SEQ + (tn & 127) * 64;
  return *(const unsigned*)(P + (tok0 + (tid >> 2)) * PC + C_S5U + (tid & 3) * 64);
}
__device__ __forceinline__ unsigned touch_prep(const Params& p, int tn) {
  if (tn >= 2048) return 0u;
  const u16* P = (const u16*)(p.ws + OFF_P);
  const int tid = tidx();
  const size_t tok0 = (size_t)tn * 16;
  if (tid < 238) return *(const unsigned*)(P + (tok0 - 1 + tid / 14) * PC + C_RW + (tid % 14) * 64);
  if (tid < 254) return *(const unsigned*)(P + (tok0 + tid - 238) * PC + C_VL);
  return 0u;
}
#define KEEP(x) asm volatile("" ::"v"(x))

#define FOR_ITEMS(N) for (int t = blockIdx.x; t < (N); t += gridDim.x)
#define RUNIT(bit, ...)                                                        \
  for (int rep_ = ((pq.probe >> (bit)) & 1) ? 0 : 1; rep_ < 2; ++rep_) {       \
    pq.dry = p.dry | (rep_ == 0);                                              \
    __VA_ARGS__                                                                \
  }
__device__ __forceinline__ void phaseB(const Params& p, int l, unsigned char* smem) {
  Params pq = p;
  RUNIT(8, FOR_ITEMS(2048) { unsigned pf = touch_prep(pq, t + gridDim.x); rwkv_prep_item(pq, l, t, smem); KEEP(pf); })
  RUNIT(9, FOR_ITEMS(2048) { unsigned pf = touch_gla(pq, t + gridDim.x, false); gla_item<false>(pq, l, t >> 9, (t >> 2) & 127, t & 3, smem); KEEP(pf); })
  RUNIT(10, FOR_ITEMS(2048) { unsigned pf = touch_ssd(pq, t + gridDim.x, false); ssd_item<false>(pq, l, t >> 9, (t >> 2) & 127, t & 3, smem); KEEP(pf); })
  RUNIT(11, FOR_ITEMS(512) s5_item<false>(pq, l, t >> 7, t & 127, smem);)
}
__device__ __forceinline__ void phaseC(const Params& p, int l, unsigned char* smem) {
  Params pq = p;
  RUNIT(12, __syncthreads(); FOR_ITEMS(16 * NSEG * 2 / 4) {
    rwkv_scan_wave<1>(pq, l, t * 4 + (tidx() >> 6), (float*)smem + (tidx() >> 6) * 3072);
  })
  RUNIT(13, FOR_ITEMS(256) {
              if (t < 128) state_scan_item(pq, (u16*)(p.ws + OFF_GST), (const float*)(p.ws + OFF_GDC), t);
              else state_scan_item(pq, (u16*)(p.ws + OFF_SST), (const float*)(p.ws + OFF_SDC), t - 128);
            }
            FOR_ITEMS(16) s5_scan_item(pq, l, t);)
  RUNIT(14, FOR_ITEMS(2048) memattn_item(pq, l, t >> 9, (t >> 7) & 3, t & 127, smem);)
}
__device__ __forceinline__ void phaseD(const Params& p, int l, unsigned char* smem) {
  Params pq = p;
  const bool split = (gridDim.x == 512);
#define FOR_REST(N) for (int t = split ? (int)blockIdx.x - 64 : (int)blockIdx.x; t >= 0 && t < (N); t += split ? 448 : (int)gridDim.x)
  RUNIT(13, FOR_ITEMS(64) rwkv_chain_item(pq, t, smem);)
  const int rst = split ? 448 : (int)gridDim.x;
  RUNIT(9, FOR_REST(4608) {
    const int tn = t + rst;
    unsigned pf = (tn < 2048) ? touch_gla(pq, tn, true) : (tn < 4096) ? touch_ssd(pq, tn - 2048, true) : touch_s5(pq, tn - 4096);
    if (t < 2048) gla_item<true>(pq, l, t >> 9, (t >> 2) & 127, t & 3, smem);
    else if (t < 4096) { const int u = t - 2048; ssd_item<true>(pq, l, u >> 9, (u >> 2) & 127, u & 3, smem); }
    else { const int u = t - 4096; s5_item<true>(pq, l, u >> 7, u & 127, smem); }
    KEEP(pf);
  })
#undef FOR_REST
}
__device__ __forceinline__ void phaseE(const Params& p, int l, unsigned char* smem) {
  Params pq = p;
  RUNIT(15, __syncthreads(); FOR_ITEMS(16 * NSEG / 4) {
    rwkv_scan_wave<3>(pq, l, t * 4 + (tidx() >> 6), (float*)smem + (tidx() >> 6) * 3072);
  })
  RUNIT(16, for (int t = (gridDim.x == 512) ? ((int)blockIdx.x >= 256 ? (int)blockIdx.x - 256 : 512) : (int)blockIdx.x; t < 512;
                 t += (gridDim.x == 512) ? 256 : (int)gridDim.x) {
    int mt = t >> 1, nt = t & 1;
    gemm_tile<EPI_GLU, false>(pq, l, (const u16*)(p.ws + OFF_P) + C_S5U, PC, (const u16*)(p.ws + OFF_GLU) + (size_t)l * 512 * 256, 256, mt * 128, nt * 256, smem);
  })
  if (l + 1 < NL) {
    const float* src = p.in[I_WINR] + (size_t)l * 1024 * 4020;
    for (int t = (gridDim.x == 512) ? ((int)blockIdx.x >= 256 ? (int)blockIdx.x - 256 : 1024) : (int)blockIdx.x; t < 1024;
         t += (gridDim.x == 512) ? 256 : (int)gridDim.x)
      tconv_tile(src, 4020, (u16*)(p.ws + OFF_WIN), 1024, (t / 16) * 64, (t % 16) * 64, 0, l + 1, (float*)smem, p.dry);
  }
}
__device__ __forceinline__ void phaseF(const Params& p, int l, unsigned char* smem) {
  FOR_ITEMS(256 * 4) {
    int mt = t >> 2, nt = t & 3;
    if (gridDim.x == 512) {
      const int r = t >> 9, x = blockIdx.x & 7, k = blockIdx.x >> 3;
      mt = x * 32 + r * 16 + (k >> 2);
      nt = k & 3;
    }
    gemm_tile<EPI_OUT, false>(p, l, (const u16*)(p.ws + OFF_P), PC, (const u16*)(p.ws + OFF_WOUT) + (size_t)l * 1024 * 1280, 1280, mt * 128, nt * 256, smem);
  }
}
__device__ __forceinline__ void phaseG(const Params& p, int l, unsigned char* smem) {
  FOR_ITEMS(NTOK / 4) ln_item(p, l, t);
}


#define XB_TMO      128
#define XB_XCNT(j)  (256  + 64 * (j))
#define XB_XSUB(j)  (1280 + 64 * (j))
#define XB_XGEN(j)  (2304 + 64 * (j))
#define XB_TOP      3328
#define XB_TOPGEN   3392
#define XCD_BAR_WORDS 3456
#define XB_SPIN_CAP (1u << 22)
#define LAS __attribute__((address_space(3)))
__device__ __forceinline__ unsigned xb_ld(unsigned* p)              { return __hip_atomic_load(p, __ATOMIC_RELAXED, __HIP_MEMORY_SCOPE_AGENT); }
__device__ __forceinline__ unsigned xb_add(unsigned* p, unsigned v) { return __hip_atomic_fetch_add(p, v, __ATOMIC_RELAXED, __HIP_MEMORY_SCOPE_AGENT); }
__device__ __forceinline__ unsigned xb_xcc_id() { return (unsigned)__builtin_amdgcn_s_getreg((3 << 11) | 20) & 0xFu; }
#define XB_SPIN(cond, bar) do { unsigned _sp = 0; while (cond) { __builtin_amdgcn_s_sleep(1); \
    if ((++_sp & 255u) == 0u) { if (xb_ld(&(bar)[XB_TMO])) break; if (_sp > XB_SPIN_CAP) { atomicAdd(&(bar)[XB_TMO], 1u); break; } } } } while (0)
struct XcdBarrier { unsigned* bar; unsigned x; volatile LAS unsigned* st; };
__device__ __forceinline__ XcdBarrier xcd_barrier_post(unsigned* bar, volatile LAS unsigned* st) {
  XcdBarrier b; b.bar = bar; b.x = xb_xcc_id(); b.st = st;
  if (threadIdx.x == 0) (void)xb_add(&bar[XB_XCNT(b.x)], 1u);
  return b;
}
__device__ __forceinline__ void xcd_barrier_complete(unsigned* bar, unsigned x, unsigned& nloc, unsigned& nx) {
  const unsigned G = gridDim.x * gridDim.y * gridDim.z;
  unsigned sum, cnt, mine, sp = 0u;
  for (;;) {
    sum = 0u; cnt = 0u; mine = 0u;
#pragma unroll
    for (unsigned j = 0; j < 16; ++j) { const unsigned c = xb_ld(&bar[XB_XCNT(j)]); sum += c; cnt += (c > 0u) ? 1u : 0u; mine = (j == x) ? c : mine; }
    if (sum == G) break;
    __builtin_amdgcn_s_sleep(1);
    if ((++sp & 255u) == 0u) { if (xb_ld(&bar[XB_TMO])) break; if (sp > XB_SPIN_CAP) { atomicAdd(&bar[XB_TMO], 1u); break; } }
  }
  nloc = mine > 0u ? mine : 1u; nx = cnt > 0u ? cnt : 1u;
}
__device__ __forceinline__ void xcd_barrier(const XcdBarrier& b) {
  asm volatile("s_waitcnt vmcnt(0)" ::: "memory");
  __syncthreads();
  if (threadIdx.x == 0) {
    unsigned* bar = b.bar;
    __builtin_amdgcn_s_waitcnt(0);
    unsigned nloc = b.st[0], nx = b.st[1];
    if (nloc == 0u) { xcd_barrier_complete(bar, b.x, nloc, nx); b.st[0] = nloc; b.st[1] = nx; }
    const unsigned old = xb_add(&bar[XB_XSUB(b.x)], 1u);
    const unsigned gen = old / nloc;
    if (old + 1u == (gen + 1u) * nloc) {
      __builtin_amdgcn_fence(__ATOMIC_RELEASE, "agent");
      asm volatile("s_waitcnt vmcnt(0)" ::: "memory");
      const unsigned og = xb_add(&bar[XB_TOP], 1u);
      const unsigned tg = og / nx;
      if (og + 1u == (tg + 1u) * nx) xb_add(&bar[XB_TOPGEN], 1u);
      else XB_SPIN(xb_ld(&bar[XB_TOPGEN]) == tg, bar);
      __builtin_amdgcn_fence(__ATOMIC_ACQUIRE, "agent");
      xb_add(&bar[XB_XGEN(b.x)], 1u);
      asm volatile("s_waitcnt vmcnt(0)" ::: "memory");
    } else {
      XB_SPIN(xb_ld(&bar[XB_XGEN(b.x)]) == gen, bar);
      __builtin_amdgcn_fence(__ATOMIC_ACQUIRE, "agent");
      asm volatile("s_waitcnt vmcnt(0)" ::: "memory");
    }
  }
  __syncthreads();
}

#if MK_ONE
__global__ void __launch_bounds__(256, 2) mega_kernel(Params p) {
  __shared__ __attribute__((aligned(16))) unsigned char smem[SMEM_BYTES];
  cg::grid_group grid = cg::this_grid();
#ifndef PROBE_SYNC
#define PROBE_SYNC 0
#endif
#define GSYNC for (int sy_ = 0; sy_ <= PROBE_SYNC; ++sy_) xcd_barrier(xb)
  __shared__ uint4 xb_words;
  if (threadIdx.x == 0) xb_words = make_uint4(0u, 0u, 0u, 0u);
  __syncthreads();
  XcdBarrier xb = xcd_barrier_post((unsigned*)(p.ws + OFF_BAR), (volatile LAS unsigned*)&xb_words);
#ifndef TESTM
#define TESTM 255
#endif
#define RUNPH(bit, call)                                              \
  for (int rep = ((pp.probe >> (bit)) & 1) ? 0 : 1; rep < 2; ++rep) {  \
    pp.dry = (rep == 0);                                              \
    call;                                                             \
  }
  Params pp = p;
  RUNPH(0, phase0(pp, smem));
  GSYNC;
#pragma unroll 1
  for (int l = 0; l < NL; ++l) {
    RUNPH(1, phaseA(pp, l, smem)); GSYNC;
    RUNPH(2, phaseB(pp, l, smem)); GSYNC;
    RUNPH(3, phaseC(pp, l, smem)); GSYNC;
    RUNPH(4, phaseD(pp, l, smem)); GSYNC;
    RUNPH(5, phaseE(pp, l, smem)); GSYNC;
    RUNPH(6, phaseF(pp, l, smem));
    if (l + 1 < NL) GSYNC;
  }
  if (p.probe == 0x7fffffff) grid.sync();
}
#else
template <int PH>
__global__ void __launch_bounds__(256, 2) phase_kernel(Params p, int l) {
  __shared__ __attribute__((aligned(16))) unsigned char smem[SMEM_BYTES];
  if (PH == 0) phase0(p, smem);
  if (PH == 1) phaseA(p, l, smem);
  if (PH == 2) phaseB(p, l, smem);
  if (PH == 3) phaseC(p, l, smem);
  if (PH == 4) phaseD(p, l, smem);
  if (PH == 5) phaseE(p, l, smem);
  if (PH == 6) phaseF(p, l, smem);
  if (PH == 7) phaseG(p, l, smem);
}
#endif

extern "C" void kernel_launch(void* const* d_in, const int* in_sizes, int n_in, void* d_out, int out_size, void* d_ws,
                              size_t ws_size, hipStream_t stream) {
  Params p{};
  for (int i = 0; i < N_IN; ++i) p.in[i] = (const float*)d_in[i];
  p.out = (float*)d_out;
  p.ws = (unsigned char*)d_ws;
#ifndef PROBE_MASK
#define PROBE_MASK 0
#endif
  p.probe = PROBE_MASK;
  p.dry = 0;
  if (ws_size < WS_TOTAL) fprintf(stderr, "workspace too small: %zu < %zu\n", ws_size, (size_t)WS_TOTAL);
#if MK_ONE
  static int grid_blocks = 0;
  if (!grid_blocks) {
    int dev = 0, cus = 0, per_cu = 0;
    hipGetDevice(&dev);
    hipDeviceGetAttribute(&cus, hipDeviceAttributeMultiprocessorCount, dev);
    hipOccupancyMaxActiveBlocksPerMultiprocessor(&per_cu, mega_kernel, 256, 0);
    if (per_cu < 1) per_cu = 1;
    if (per_cu > 2) per_cu = 2;
    grid_blocks = cus * per_cu;
  }
  hipMemsetAsync((unsigned char*)d_ws + OFF_BAR, 0, 16384, stream);
  void* args[] = {&p};
  hipError_t e = hipLaunchCooperativeKernel((void*)mega_kernel, dim3(grid_blocks), dim3(256), args, 0, stream);
  if (e != hipSuccess) fprintf(stderr, "cooperative launch failed: %s (grid %d)\n", hipGetErrorString(e), grid_blocks);
#else
  const int G = 1024;
  phase_kernel<0><<<G, 256, 0, stream>>>(p, 0);
  for (int l = 0; l < NL; ++l) {
    phase_kernel<1><<<G, 256, 0, stream>>>(p, l);
    phase_kernel<2><<<G, 256, 0, stream>>>(p, l);
    phase_kernel<3><<<G, 256, 0, stream>>>(p, l);
    phase_kernel<4><<<G, 256, 0, stream>>>(p, l);
    phase_kernel<5><<<G, 256, 0, stream>>>(p, l);
    phase_kernel<6><<<G, 256, 0, stream>>>(p, l);
    phase_kernel<7><<<G, 256, 0, stream>>>(p, l);
  }
#endif
}
```

```cpp
#include <hip/hip_runtime.h>
#include <hip/hip_cooperative_groups.h>
#include <cstdio>
namespace cg = cooperative_groups;

#ifndef MK_ONE
#define MK_ONE 1
#endif

typedef unsigned short u16;
using bf16x8 = __attribute__((ext_vector_type(8))) short;
using f32x4 = __attribute__((ext_vector_type(4))) float;

constexpr int NTOK = 32768, SEQ = 8192, NL = 4;
constexpr int PC = 4032;
constexpr int C_GQ = 1280, C_GK = 1536, C_GV = 1792, C_XBC = 2048, C_S5U = 2560, C_RW = 2816, C_MQ = 3712,
              C_GA = 3968, C_DT = 3984, C_VL = 4000;
constexpr int NSEG = 64, SEGLEN = 128;
constexpr float ALPHA = 1.6817928305074290f;

enum { I_X, I_MEM, I_WIN0, I_WINR, I_GLA_WA2, I_GLA_BA, I_GLA_NW, I_SSD_CW, I_SSD_CB, I_SSD_DTB, I_SSD_ALOG, I_SSD_D,
       I_SSD_NW, I_S5_ARE, I_S5_AIM, I_S5_BRE, I_S5_BIM, I_S5_CRE, I_S5_CIM, I_S5_LOGDT, I_S5_D, I_S5_GLUW, I_S5_GLUB,
       I_RW_MU, I_RW_W0, I_RW_W2, I_RW_A0, I_RW_A2, I_RW_V0, I_RW_V2, I_RW_KK, I_RW_KA, I_RW_RK, I_RW_GNW, I_RW_GNB,
       I_MEM_WKV, I_WOUT, I_LNW, I_LNB, N_IN };

struct Params {
  const float* in[N_IN];
  float* out;
  unsigned char* ws;
  int probe;
  int dry;
};

constexpr size_t SZ_P = (size_t)NTOK * PC * 2;
constexpr size_t OFF_P = 0;
constexpr size_t OFF_WIN = OFF_P + SZ_P;
constexpr size_t OFF_WOUT = OFF_WIN + (size_t)1 * 4096 * 1024 * 2;
constexpr size_t OFF_GLU = OFF_WOUT + (size_t)4 * 1024 * 1280 * 2;
constexpr size_t OFF_MKV = OFF_GLU + (size_t)4 * 512 * 256 * 2;
constexpr size_t OFF_S5A = OFF_MKV + (size_t)4 * 512 * 1024 * 2;
constexpr size_t OFF_S5A64 = OFF_S5A + 4 * 16 * 64 * 2 * 4;
constexpr size_t OFF_S5B = OFF_S5A64 + 4 * 16 * 64 * 2 * 4;
constexpr size_t OFF_S5C = OFF_S5B + (size_t)4 * 16 * 128 * 32 * 2;
constexpr size_t OFF_KM = OFF_S5C + (size_t)4 * 16 * 16 * 128 * 2;
constexpr size_t OFF_VMT = OFF_KM + (size_t)4 * 1024 * 256 * 2;
constexpr size_t OFF_PREP = OFF_VMT + (size_t)4 * 4 * 256 * 256 * 2;
constexpr size_t SZ_PREP1 = (size_t)NTOK * 256 * 2;
constexpr size_t OFF_VF = OFF_PREP + 6 * SZ_PREP1;
constexpr size_t OFF_GST = OFF_VF + SZ_PREP1;
constexpr size_t SZ_ST = (size_t)4 * 128 * 4 * 4096 * 4;
constexpr size_t OFF_GDC = OFF_GST + SZ_ST;
constexpr size_t SZ_DC = (size_t)4 * 128 * 4 * 64 * 4;
constexpr size_t OFF_SST = OFF_GDC + SZ_DC;
constexpr size_t OFF_SDC = OFF_SST + SZ_ST;
constexpr size_t OFF_S5X = OFF_SDC + SZ_DC;
constexpr size_t OFF_RSL = OFF_S5X + (size_t)4 * 128 * 16 * 64 * 2 * 4;
constexpr size_t SZ_RS = (size_t)16 * NSEG * 4096 * 4;
constexpr size_t OFF_RPM = OFF_RSL + SZ_RS;
constexpr size_t OFF_BAR = OFF_RPM + SZ_RS;
constexpr size_t OFF_MEMB = OFF_BAR + 16384;
constexpr size_t OFF_LNX = OFF_MEMB + (size_t)1024 * 1024 * 2;
constexpr size_t OFF_W2T = OFF_LNX + (size_t)256 * 4 * 128 * 8;
constexpr size_t OFF_A2T = OFF_W2T + (size_t)4 * 256 * 64 * 2;
constexpr size_t OFF_V2T = OFF_A2T + (size_t)4 * 256 * 64 * 2;
constexpr size_t OFF_W2L = OFF_V2T + (size_t)3 * 256 * 32 * 2;
constexpr size_t WS_TOTAL = OFF_W2L + (size_t)4 * 256 * 64 * 2;

constexpr int SMEM_BYTES = 49152;

__device__ __forceinline__ int tidx() { int t = threadIdx.x; asm volatile("" : "+v"(t)); return t; }
__device__ __forceinline__ u16 f2bf(float f) {
  unsigned u = __float_as_uint(f);
  u += 0x7fffu + ((u >> 16) & 1u);
  return (u16)(u >> 16);
}
__device__ __forceinline__ float bf2f(u16 h) { return __uint_as_float(((unsigned)h) << 16); }
__device__ __forceinline__ float sigm(float x) { return 1.f / (1.f + __expf(-x)); }
__device__ __forceinline__ float silu(float x) { return x / (1.f + __expf(-x)); }
__device__ __forceinline__ float softplus(float x) { return fmaxf(x, 0.f) + log1pf(__expf(-fabsf(x))); }
__device__ __forceinline__ float gelu_tanh(float x) {
  float u = 0.7978845608028654f * (x + 0.044715f * x * x * x);
  return 0.5f * x * (1.f + tanhf(u));
}
#define DPP_ADD(v, CTRL) ((v) + __int_as_float(__builtin_amdgcn_update_dpp(0, __float_as_int(v), (CTRL), 0xf, 0xf, false)))
__device__ __forceinline__ float wave_sum(float v) {
  v = DPP_ADD(v, 0xB1);
  v = DPP_ADD(v, 0x4E);
  v = DPP_ADD(v, 0x141);
  v = DPP_ADD(v, 0x140);
  const int iv = __float_as_int(v);
  return __int_as_float(__builtin_amdgcn_readlane(iv, 0)) + __int_as_float(__builtin_amdgcn_readlane(iv, 16)) +
         __int_as_float(__builtin_amdgcn_readlane(iv, 32)) + __int_as_float(__builtin_amdgcn_readlane(iv, 48));
}
__device__ __forceinline__ float sum16(float v) {
#pragma unroll
  for (int m = 8; m >= 1; m >>= 1) v += __shfl_xor(v, m, 64);
  return v;
}
__device__ __forceinline__ float max16(float v) {
#pragma unroll
  for (int m = 8; m >= 1; m >>= 1) v = fmaxf(v, __shfl_xor(v, m, 64));
  return v;
}

template <int NT, int KS>
__device__ __forceinline__ void mma_strip(const u16* A, int lda, const u16* Bt, int ldb, f32x4 (&acc)[NT]) {
  const int lane = tidx() & 63, fr = lane & 15, fq = lane >> 4;
#pragma unroll
  for (int ks = 0; ks < KS; ++ks) {
    bf16x8 a = *(const bf16x8*)(A + fr * lda + ks * 32 + fq * 8);
#pragma unroll
    for (int n = 0; n < NT; ++n) {
      bf16x8 b = *(const bf16x8*)(Bt + (n * 16 + fr) * ldb + ks * 32 + fq * 8);
      acc[n] = __builtin_amdgcn_mfma_f32_16x16x32_bf16(a, b, acc[n], 0, 0, 0);
    }
  }
}

template <int NT, int KS>
__device__ __forceinline__ void mma_strip_t(const u16* A, int lda, const u16* Bt, int ldb, f32x4 (&acc)[NT]) {
  const int lane = tidx() & 63, fr = lane & 15, fq = lane >> 4;
#pragma unroll
  for (int ks = 0; ks < KS; ++ks) {
    bf16x8 a = *(const bf16x8*)(A + fr * lda + ks * 32 + fq * 8);
#pragma unroll
    for (int n = 0; n < NT; ++n) {
      bf16x8 b = *(const bf16x8*)(Bt + (n * 16 + fr) * ldb + ks * 32 + fq * 8);
      acc[n] = __builtin_amdgcn_mfma_f32_16x16x32_bf16(b, a, acc[n], 0, 0, 0);
    }
  }
}
__device__ __forceinline__ uint2 pack4(float a, float b, float c, float d) {
  uint2 o;
  o.x = (unsigned)f2bf(a) | ((unsigned)f2bf(b) << 16);
  o.y = (unsigned)f2bf(c) | ((unsigned)f2bf(d) << 16);
  return o;
}
__device__ __forceinline__ void unpack4(const uint2& u, float* o) {
  o[0] = __uint_as_float(u.x << 16); o[1] = __uint_as_float(u.x & 0xffff0000u);
  o[2] = __uint_as_float(u.y << 16); o[3] = __uint_as_float(u.y & 0xffff0000u);
}

enum { EPI_P, EPI_MEMKV, EPI_OUT, EPI_GLU };

template <int EPI, bool AF32>
__device__ __forceinline__ void gemm_tile(const Params& p, int layer, const void* Av, int lda, const u16* Bt, int K, int m0, int n0,
                          unsigned char* smem) {
  u16* sA = (u16*)smem;
  u16* sB = sA + 2 * 128 * 32;
  const int tid = tidx(), lane = tid & 63, w = tid >> 6, wr = w >> 1, wc = w & 1, fr = lane & 15, fq = lane >> 4;
  f32x4 acc[4][8];
#pragma unroll
  for (int m = 0; m < 4; ++m)
#pragma unroll
    for (int n = 0; n < 8; ++n) acc[m][n] = f32x4{0.f, 0.f, 0.f, 0.f};
  uint4 qa0_0, qa0_1, qb0_0, qb0_1, qb0_2, qb0_3;
  uint4 qa1_0, qa1_1, qb1_0, qb1_1, qb1_2, qb1_3;
  const int nk = K / 32;
  const u16* Ag = (const u16*)Av;
  const int lrow = tid >> 2, lc8 = (tid & 3) * 8;
  const u16* gA = Ag + (size_t)(m0 + lrow) * lda + lc8;
  const u16* gB = Bt + (size_t)(n0 + lrow) * K + lc8;
  const size_t a64 = (size_t)64 * lda, b64 = (size_t)64 * K;
  const int sw = lrow * 32 + (((tid & 3) ^ ((lrow >> 2) & 3)) * 8);
  const int rsw = (fq ^ ((fr >> 2) & 3)) * 8;
  __syncthreads();
#define GLOAD(S, kt)                                   \
  {                                                    \
    const int k0 = (kt) * 32;                          \
    qa##S##_0 = *(const uint4*)(gA + k0);              \
    qa##S##_1 = *(const uint4*)(gA + a64 + k0);        \
    qb##S##_0 = *(const uint4*)(gB + k0);              \
    qb##S##_1 = *(const uint4*)(gB + b64 + k0);        \
    qb##S##_2 = *(const uint4*)(gB + 2 * b64 + k0);    \
    qb##S##_3 = *(const uint4*)(gB + 3 * b64 + k0);    \
  }
#define SSTORE(S, buf)                                 \
  {                                                    \
    u16* a_ = sA + (buf) * 128 * 32;                   \
    u16* b_ = sB + (buf) * 256 * 32;                   \
    *(uint4*)(a_ + sw) = qa##S##_0;                    \
    *(uint4*)(a_ + 64 * 32 + sw) = qa##S##_1;          \
    *(uint4*)(b_ + sw) = qb##S##_0;                    \
    *(uint4*)(b_ + 64 * 32 + sw) = qb##S##_1;          \
    *(uint4*)(b_ + 128 * 32 + sw) = qb##S##_2;         \
    *(uint4*)(b_ + 192 * 32 + sw) = qb##S##_3;         \
  }
#define GSTEP(U, S)                                                                                 \
  {                                                                                                 \
    const int kt = kt0 + (U);                                                                       \
    if (kt < nk) {                                                                                  \
      {                                                                                             \
        const u16* a_ = sA + (kt & 1) * 128 * 32 + (wr * 64) * 32;                                  \
        const u16* b_ = sB + (kt & 1) * 256 * 32 + (wc * 128) * 32;                                 \
        bf16x8 af[4];                                                                               \
        _Pragma("unroll") for (int m = 0; m < 4; ++m) af[m] = *(const bf16x8*)(a_ + (m * 16 + fr) * 32 + rsw);      \
        __builtin_amdgcn_s_setprio(1);                                                              \
        _Pragma("unroll") for (int nh = 0; nh < 2; ++nh) {                                          \
          bf16x8 bfr[4];                                                                            \
          _Pragma("unroll") for (int n = 0; n < 4; ++n) bfr[n] = *(const bf16x8*)(b_ + ((nh * 4 + n) * 16 + fr) * 32 + rsw); \
          _Pragma("unroll") for (int m = 0; m < 4; ++m)                                             \
            _Pragma("unroll") for (int n = 0; n < 4; ++n)                                           \
              acc[m][nh * 4 + n] = __builtin_amdgcn_mfma_f32_16x16x32_bf16(bfr[n], af[m], acc[m][nh * 4 + n], 0, 0, 0); \
        }                                                                                           \
        __builtin_amdgcn_s_setprio(0);                                                              \
      }                                                                                             \
      if (kt + 1 < nk) SSTORE(S, (kt + 1) & 1);                                                     \
      if (kt + 2 < nk) GLOAD(0, kt + 2);                                                            \
      __syncthreads();                                                                              \
    }                                                                                               \
  }
  GLOAD(0, 0);
  qa1_0 = qa1_1 = qb1_0 = qb1_1 = qb1_2 = qb1_3 = make_uint4(0, 0, 0, 0);
  if (nk > 1) GLOAD(1, 1);
  SSTORE(0, 0);
  __syncthreads();
  {
    const int kt0 = 0;
    GSTEP(0, 1);
  }
#pragma unroll 1
  for (int kt0 = 1; kt0 < nk; ++kt0) {
    GSTEP(0, 0);
  }
#undef GLOAD
#undef SSTORE
#undef GSTEP
  u16* P = (u16*)(p.ws + OFF_P);
  if (EPI == EPI_GLU) {
    const float* gb = p.in[I_S5_GLUB] + layer * 512;
#pragma unroll
    for (int m = 0; m < 4; ++m)
#pragma unroll
      for (int n2 = 0; n2 < 4; ++n2) {
        if ((n2 & 1) == 0) __builtin_amdgcn_sched_barrier(0);
        const int cb = n0 + wc * 128 + n2 * 32;
        const int c0 = (cb >> 5) * 16 + fq * 4;
        const int row = m0 + wr * 64 + m * 16 + fr;
        const size_t a = (size_t)row * PC + 512 + c0;
        const uint2 gq = *(const uint2*)(P + a);
        const float g[4] = {__uint_as_float(gq.x << 16), __uint_as_float(gq.x & 0xffff0000u),
                            __uint_as_float(gq.y << 16), __uint_as_float(gq.y & 0xffff0000u)};
        float o[4];
#pragma unroll
        for (int j = 0; j < 4; ++j) {
          float val = acc[m][n2 * 2][j] + gb[c0 + j];
          float gt = acc[m][n2 * 2 + 1][j] + gb[256 + c0 + j];
          o[j] = val * sigm(gt) * silu(g[j]);
        }
        uint2 ov;
        ov.x = (unsigned)f2bf(o[0]) | ((unsigned)f2bf(o[1]) << 16);
        ov.y = (unsigned)f2bf(o[2]) | ((unsigned)f2bf(o[3]) << 16);
        if (!p.dry) *(uint2*)(P + a) = ov;
      }
    return;
  }
  if (EPI == EPI_P) {
    u16* cw = (u16*)smem + w * (64 * 72);
#pragma unroll
    for (int nh = 0; nh < 2; ++nh) {
      if (nh) __syncthreads();
#pragma unroll
      for (int m = 0; m < 4; ++m)
#pragma unroll
        for (int n = 0; n < 4; ++n) {
          const f32x4 v = acc[m][nh * 4 + n];
          uint2 ov;
          ov.x = (unsigned)f2bf(v[0]) | ((unsigned)f2bf(v[1]) << 16);
          ov.y = (unsigned)f2bf(v[2]) | ((unsigned)f2bf(v[3]) << 16);
          *(uint2*)(cw + (m * 16 + fr) * 72 + n * 16 + fq * 4) = ov;
        }
      __syncthreads();
      const int colb = n0 + wc * 128 + nh * 64;
      if (colb < PC && !p.dry) {
#pragma unroll
        for (int i = 0; i < 8; ++i) {
          const int r = i * 8 + (lane >> 3), c8 = (lane & 7) * 8;
          const uint4 v = *(const uint4*)(cw + r * 72 + c8);
          *(uint4*)(P + (size_t)(m0 + wr * 64 + r) * PC + colb + c8) = v;
        }
      }
    }
    return;
  }
  if (EPI == EPI_OUT) {
    if (p.dry) return;
    const float* xr = (layer == 0) ? p.in[I_X] : p.out;
    float s1[4], s2[4];
#pragma unroll
    for (int m = 0; m < 4; ++m) {
      const int row = m0 + wr * 64 + m * 16 + fr;
      float a1 = 0.f, a2 = 0.f;
#pragma unroll
      for (int n = 0; n < 8; ++n) {
        const int col = n0 + wc * 128 + n * 16 + fq * 4;
        const float4 xv = *(const float4*)(xr + (size_t)row * 1024 + col);
        f32x4 z = acc[m][n];
        z[0] += ALPHA * xv.x; z[1] += ALPHA * xv.y; z[2] += ALPHA * xv.z; z[3] += ALPHA * xv.w;
        acc[m][n] = z;
        a1 += z[0] + z[1] + z[2] + z[3];
        a2 += z[0] * z[0] + z[1] * z[1] + z[2] * z[2] + z[3] * z[3];
      }
      a1 += __shfl_xor(a1, 16, 64); a1 += __shfl_xor(a1, 32, 64);
      a2 += __shfl_xor(a2, 16, 64); a2 += __shfl_xor(a2, 32, 64);
      s1[m] = a1; s2[m] = a2;
    }
    float* red = (float*)smem;
    if (fq == 0) {
#pragma unroll
      for (int m = 0; m < 4; ++m) {
        const int rl = wr * 64 + m * 16 + fr;
        red[(rl * 2 + wc) * 2] = s1[m];
        red[(rl * 2 + wc) * 2 + 1] = s2[m];
      }
    }
    __syncthreads();
    const int mt = m0 >> 7, nt = n0 >> 8;
    unsigned long long* lnx = (unsigned long long*)(p.ws + OFF_LNX);
    unsigned* cnt = (unsigned*)(p.ws + OFF_BAR) + 3584 + mt;
    if (tid < 128) {
      const float t1 = red[(tid * 2) * 2] + red[(tid * 2 + 1) * 2];
      const float t2 = red[(tid * 2) * 2 + 1] + red[(tid * 2 + 1) * 2 + 1];
      const unsigned long long pk = ((unsigned long long)__float_as_uint(t2) << 32) | (unsigned long long)__float_as_uint(t1);
      __hip_atomic_store(lnx + ((size_t)mt * 4 + nt) * 128 + tid, pk, __ATOMIC_RELAXED, __HIP_MEMORY_SCOPE_AGENT);
    }
    asm volatile("s_waitcnt vmcnt(0)" ::: "memory");
    __syncthreads();
    if (tid == 0) {
      __hip_atomic_fetch_add(cnt, 1u, __ATOMIC_RELEASE, __HIP_MEMORY_SCOPE_AGENT);
      const unsigned target = 4u * (unsigned)(layer + 1);
      unsigned spins = 0;
      while (__hip_atomic_load(cnt, __ATOMIC_RELAXED, __HIP_MEMORY_SCOPE_AGENT) < target) {
        __builtin_amdgcn_s_sleep(1);
        if (++spins > (1u << 24)) break;
      }
      __builtin_amdgcn_fence(__ATOMIC_ACQUIRE, "agent");
    }
    __syncthreads();
    const float* lw = p.in[I_LNW] + layer * 1024;
    const float* lb = p.in[I_LNB] + layer * 1024;
    u16* Xb = (u16*)(p.ws + OFF_PREP);
#pragma unroll
    for (int m = 0; m < 4; ++m) {
      const int rl = wr * 64 + m * 16 + fr;
      const int row = m0 + rl;
      float t1 = 0.f, t2 = 0.f;
#pragma unroll
      for (int q = 0; q < 4; ++q) {
        const unsigned long long pk = __hip_atomic_load(lnx + ((size_t)mt * 4 + q) * 128 + rl, __ATOMIC_RELAXED, __HIP_MEMORY_SCOPE_AGENT);
        t1 += __uint_as_float((unsigned)(pk & 0xffffffffull));
        t2 += __uint_as_float((unsigned)(pk >> 32));
      }
      const float mean = t1 * (1.f / 1024.f);
      const float var = fmaxf(t2 * (1.f / 1024.f) - mean * mean, 0.f);
      const float rs = rsqrtf(var + 1e-5f);
#pragma unroll
      for (int n = 0; n < 8; ++n) {
        const int col = n0 + wc * 128 + n * 16 + fq * 4;
        const float4 wv = *(const float4*)(lw + col);
        const float4 bv = *(const float4*)(lb + col);
        const f32x4 z = acc[m][n];
        float4 o;
        o.x = (z[0] - mean) * rs * wv.x + bv.x;
        o.y = (z[1] - mean) * rs * wv.y + bv.y;
        o.z = (z[2] - mean) * rs * wv.z + bv.z;
        o.w = (z[3] - mean) * rs * wv.w + bv.w;
        *(float4*)(p.out + (size_t)row * 1024 + col) = o;
        if (layer + 1 < NL) *(uint2*)(Xb + (size_t)row * 1024 + col) = pack4(o.x, o.y, o.z, o.w);
      }
    }
    return;
  }
#pragma unroll
  for (int m = 0; m < 4; ++m)
#pragma unroll
    for (int n = 0; n < 8; ++n) {
      if ((n & 3) == 0) __builtin_amdgcn_sched_barrier(0);
      const int row = m0 + wr * 64 + m * 16 + fr;
      const int col = n0 + wc * 128 + n * 16 + fq * 4;
      const f32x4 v = acc[m][n];
      if (EPI == EPI_MEMKV) {
        u16* km = (u16*)(p.ws + OFF_KM) + (size_t)layer * 1024 * 256;
        u16* vmT = (u16*)(p.ws + OFF_VMT) + (size_t)layer * 4 * 256 * 256;
        if (!p.dry) {
#pragma unroll
          for (int j = 0; j < 4; ++j) {
            int cj = col + j;
            if (cj < 256) km[(size_t)row * 256 + cj] = f2bf(v[j]);
            else {
              int b = row >> 8, mm = row & 255;
              vmT[((size_t)b * 256 + (cj - 256)) * 256 + mm] = f2bf(v[j]);
            }
          }
        }
      } else if (EPI == EPI_OUT) {
        const float* xr = (layer == 0) ? p.in[I_X] : p.out;
        const size_t a = (size_t)row * 1024 + col;
        const float4 xv = *(const float4*)(xr + a);
        float4 o;
        o.x = ALPHA * xv.x + v[0]; o.y = ALPHA * xv.y + v[1]; o.z = ALPHA * xv.z + v[2]; o.w = ALPHA * xv.w + v[3];
        if (!p.dry) *(float4*)(p.out + a) = o;
      }
    }
}

__device__ __forceinline__ int win_src_col(int n, int layer) {
  if (n < 2048) return n;
  if (n < 2560) return n - 2048 + 2064;
  if (n < 2816) return n - 2560 + 2580;
  if (n < 3712) return n - 2816 + 2836;
  if (n < 3968) return n - 3712 + 3732;
  if (n < 3984) return n - 3968 + 2048;
  if (n < 3988) return n - 3984 + 2576;
  if (n < 4000) return -1;
  if (n < 4032) return layer == 0 ? -1 : (n - 4000 + 3988);
  return -1;
}
__device__ __forceinline__ void tconv_tile(const float* src, int src_ld, u16* dst, int K, int n0, int k0, int kind, int layer, float* tile, int dry = 0) {
  const int tid = tidx();
  __syncthreads();
  {
    int nn = tid & 63, n = n0 + nn;
    int sc;
    if (kind == 0) sc = win_src_col(n, layer);
    else if (kind == 1) sc = n;
    else sc = ((n >> 5) * 16 + (n & 15)) + 256 * ((n >> 4) & 1);
#pragma unroll
    for (int i = 0; i < 16; ++i) {
      int kk = (tid >> 6) + 4 * i;
      float v = (sc >= 0) ? src[(size_t)(k0 + kk) * src_ld + sc] : 0.f;
      tile[kk * 65 + nn] = v;
    }
  }
  __syncthreads();
  {
    int kk = tid & 63;
#pragma unroll
    for (int i = 0; i < 16; ++i) {
      int nn = (tid >> 6) + 4 * i;
      if (!dry) dst[(size_t)(n0 + nn) * K + k0 + kk] = f2bf(tile[kk * 65 + nn]);
    }
  }
}

__device__ __forceinline__ void s5_params_item(const Params& p, int l, int g) {
  const int tid = tidx();
  float* Abar = (float*)(p.ws + OFF_S5A) + ((size_t)(l * 16 + g) * 64) * 2;
  float* A64 = (float*)(p.ws + OFF_S5A64) + ((size_t)(l * 16 + g) * 64) * 2;
  u16* Bb = (u16*)(p.ws + OFF_S5B) + (size_t)(l * 16 + g) * 128 * 32;
  u16* Cm = (u16*)(p.ws + OFF_S5C) + (size_t)(l * 16 + g) * 16 * 128;
  const int pp = tid & 63, sub = tid >> 6;
  float are = p.in[I_S5_ARE][(l * 16 + g) * 64 + pp], aim = p.in[I_S5_AIM][(l * 16 + g) * 64 + pp];
  float dt = expf(p.in[I_S5_LOGDT][l * 16 + g]);
  float mag = expf(are * dt);
  float sn, cs;
  sincosf(aim * dt, &sn, &cs);
  float abr = mag * cs, abi = mag * sn;
  float nr = abr - 1.f, ni = abi;
  float den = are * are + aim * aim;
  float fr_ = (nr * are + ni * aim) / den, fi_ = (ni * are - nr * aim) / den;
  if (sub == 0) {
    Abar[pp * 2] = abr; Abar[pp * 2 + 1] = abi;
    float xr = abr, xi = abi;
#pragma unroll
    for (int i = 0; i < 6; ++i) { float t = xr * xr - xi * xi; xi = 2.f * xr * xi; xr = t; }
    A64[pp * 2] = xr; A64[pp * 2 + 1] = xi;
  }
  for (int hh = sub * 4; hh < sub * 4 + 4; ++hh) {
    size_t bi = ((size_t)(l * 16 + g) * 64 + pp) * 16 + hh;
    float bre = p.in[I_S5_BRE][bi], bim = p.in[I_S5_BIM][bi];
    Bb[pp * 32 + hh] = f2bf(fr_ * bre - fi_ * bim);
    Bb[(64 + pp) * 32 + hh] = f2bf(fr_ * bim + fi_ * bre);
    Bb[pp * 32 + 16 + hh] = 0;
    Bb[(64 + pp) * 32 + 16 + hh] = 0;
  }
  for (int hh = sub * 4; hh < sub * 4 + 4; ++hh) {
    size_t ci = ((size_t)(l * 16 + g) * 16 + hh) * 64 + pp;
    Cm[hh * 128 + pp] = f2bf(p.in[I_S5_CRE][ci]);
    Cm[hh * 128 + 64 + pp] = f2bf(-p.in[I_S5_CIM][ci]);
  }
}

__device__ __forceinline__ void cvt_bf16_rows(const Params& p, const float* src, u16* dst, size_t n4) {
  for (size_t i = (size_t)blockIdx.x * 256 + tidx(); i < n4; i += (size_t)gridDim.x * 256) {
    float4 v = ((const float4*)src)[i];
    uint2 o;
    o.x = (unsigned)f2bf(v.x) | ((unsigned)f2bf(v.y) << 16);
    o.y = (unsigned)f2bf(v.z) | ((unsigned)f2bf(v.w) << 16);
    if (!p.dry) ((uint2*)dst)[i] = o;
  }
}
__device__ __forceinline__ void phase0(const Params& p, unsigned char* smem) {
  float* tile = (float*)smem;
  cvt_bf16_rows(p, p.in[I_X], (u16*)(p.ws + OFF_PREP), (size_t)NTOK * 1024 / 4);
  cvt_bf16_rows(p, p.in[I_MEM], (u16*)(p.ws + OFF_MEMB), (size_t)1024 * 1024 / 4);
  const int T_WIN = 1 * 64 * 16, T_WOUT = 4 * 16 * 20, T_GLU = 4 * 8 * 4, T_MKV = 4 * 8 * 16, T_S5 = 64;
  const int total = T_WIN + T_WOUT + T_GLU + T_MKV + T_S5;
  for (int it = blockIdx.x; it < total; it += gridDim.x) {
    int t = it;
    if (t < T_WIN) {
      int l = t / 1024, r = t % 1024, nt = r / 16, kt = r % 16;
      const float* src = (l == 0) ? p.in[I_WIN0] : p.in[I_WINR] + (size_t)(l - 1) * 1024 * 4020;
      tconv_tile(src, l == 0 ? 3988 : 4020, (u16*)(p.ws + OFF_WIN), 1024, nt * 64, kt * 64, 0, l, tile);
      continue;
    }
    t -= T_WIN;
    if (t < T_WOUT) {
      int l = t / 320, r = t % 320, nt = r / 20, kt = r % 20;
      tconv_tile(p.in[I_WOUT] + (size_t)l * 1280 * 1024, 1024, (u16*)(p.ws + OFF_WOUT) + (size_t)l * 1024 * 1280, 1280, nt * 64, kt * 64, 1, l, tile);
      continue;
    }
    t -= T_WOUT;
    if (t < T_GLU) {
      int l = t / 32, r = t % 32, nt = r / 4, kt = r % 4;
      tconv_tile(p.in[I_S5_GLUW] + (size_t)l * 256 * 512, 512, (u16*)(p.ws + OFF_GLU) + (size_t)l * 512 * 256, 256, nt * 64, kt * 64, 2, l, tile);
      continue;
    }
    t -= T_GLU;
    if (t < T_MKV) {
      int l = t / 128, r = t % 128, nt = r / 16, kt = r % 16;
      tconv_tile(p.in[I_MEM_WKV] + (size_t)l * 1024 * 512, 512, (u16*)(p.ws + OFF_MKV) + (size_t)l * 512 * 1024, 1024, nt * 64, kt * 64, 1, l, tile);
      continue;
    }
    t -= T_MKV;
    s5_params_item(p, t / 16, t % 16);
  }
  {
    u16* W2T = (u16*)(p.ws + OFF_W2T);
    u16* A2T = (u16*)(p.ws + OFF_A2T);
    u16* V2T = (u16*)(p.ws + OFF_V2T);
    for (int i = blockIdx.x * 256 + tidx(); i < 4 * 256 * 64; i += gridDim.x * 256) {
      const int ll = i >> 14, cc = (i >> 6) & 255, j = i & 63;
      if (!p.dry) {
        const float wv_ = p.in[I_RW_W2][((size_t)ll * 64 + j) * 256 + cc];
        const u16 wh_ = f2bf(wv_);
        W2T[i] = wh_;
        ((u16*)(p.ws + OFF_W2L))[i] = f2bf(wv_ - bf2f(wh_));
        A2T[i] = f2bf(p.in[I_RW_A2][((size_t)ll * 64 + j) * 256 + cc]);
      }
    }
    for (int i = blockIdx.x * 256 + tidx(); i < 3 * 256 * 32; i += gridDim.x * 256) {
      const int ll = i >> 13, cc = (i >> 5) & 255, j = i & 31;
      if (!p.dry) V2T[i] = f2bf(p.in[I_RW_V2][((size_t)ll * 32 + j) * 256 + cc]);
    }
  }
}

__device__ __forceinline__ void phaseA(const Params& p, int l, unsigned char* smem) {
  const int T_IN = 256 * 16, T_KV = (l == 0) ? 4 * 8 * 2 : 0;
  for (int it = blockIdx.x; it < T_IN + T_KV; it += gridDim.x) {
    if (it < T_IN) {
      int mt = it / 16, nt = it % 16;
      if (gridDim.x == 512) {
        const int r = it >> 9, x = blockIdx.x & 7, k = blockIdx.x >> 3;
        mt = x * 32 + (r >> 1) * 8 + (k >> 3);
        nt = (r & 1) * 8 + (k & 7);
      }
      gemm_tile<EPI_P, false>(p, l, (const u16*)(p.ws + OFF_PREP), 1024, (const u16*)(p.ws + OFF_WIN), 1024, mt * 128, nt * 256, smem);
    } else {
      int t = it - T_IN, ll = t >> 4, mt = (t & 15) / 2, nt = t & 1;
      gemm_tile<EPI_MEMKV, false>(p, ll, (const u16*)(p.ws + OFF_MEMB), 1024, (const u16*)(p.ws + OFF_MKV) + (size_t)ll * 512 * 1024, 1024, mt * 128, nt * 256, smem);
    }
  }
}

template <bool OUT>
__device__ __forceinline__ void gla_item(const Params& p, int l, int b, int c, int h, unsigned char* smem) {
  u16* P = (u16*)(p.ws + OFF_P);
  const int tid = tidx(), lane = tid & 63, w = tid >> 6, fr = lane & 15, fq = lane >> 4;
  const int kc = lane, sq = w;
  u16* t0 = (u16*)smem;
  u16* t1 = t0 + 64 * 72;
  u16* t2 = t1 + 64 * 72;
  u16* t3 = t2 + 64 * 72;
  u16* t4 = t3 + 64 * 72;
  float* tot = (float*)(t4 + 64 * 72);
  const size_t tok0 = (size_t)b * SEQ + c * 64;
  u16* gst = (u16*)(p.ws + OFF_GST) + ((size_t)((b * 128 + c) * 4 + h)) * 4096;
  __syncthreads();
  unsigned qraw[16], kraw[16], vraw16[16];
#pragma unroll
  for (int i = 0; i < 16; ++i) {
    const size_t tok = tok0 + sq * 16 + i;
    kraw[i] = P[tok * PC + C_GK + h * 64 + kc];
    vraw16[i] = P[tok * PC + C_GV + h * 64 + kc];
    qraw[i] = OUT ? (unsigned)P[tok * PC + C_GQ + h * 64 + kc] : 0u;
  }
  uint4 spv0 = make_uint4(0, 0, 0, 0), spv1 = spv0;
  uint2 gq4[4];
  if (OUT) {
    spv0 = *(const uint4*)(gst + tid * 8);
    spv1 = *(const uint4*)(gst + (tid + 256) * 8);
#pragma unroll
    for (int n = 0; n < 4; ++n) gq4[n] = *(const uint2*)(P + (tok0 + w * 16 + fr) * PC + h * 64 + n * 16 + fq * 4);
  }
  float wa[16];
#pragma unroll
  for (int r = 0; r < 16; ++r) wa[r] = p.in[I_GLA_WA2][(size_t)(l * 16 + r) * 256 + h * 64 + kc];
  const float ba = p.in[I_GLA_BA][l * 256 + h * 64 + kc];
  float bc[16];
  float run = 0.f;
#pragma unroll
  for (int i = 0; i < 16; ++i) {
    size_t tok = tok0 + sq * 16 + i;
    const uint4* ap = (const uint4*)(P + tok * PC + C_GA);
    uint4 a0 = ap[0], a1 = ap[1];
    unsigned aw[8] = {a0.x, a0.y, a0.z, a0.w, a1.x, a1.y, a1.z, a1.w};
    float z = ba;
#pragma unroll
    for (int r = 0; r < 8; ++r) {
      z += bf2f((u16)(aw[r] & 0xffff)) * wa[2 * r];
      z += bf2f((u16)(aw[r] >> 16)) * wa[2 * r + 1];
    }
    float la = -(fmaxf(-z, 0.f) + __logf(1.f + __expf(-fabsf(z)))) * (1.f / 16.f);
    run += la;
    bc[i] = run;
  }
  tot[sq * 64 + kc] = run;
  __syncthreads();
  float prefix = 0.f, blast = 0.f;
#pragma unroll
  for (int q = 0; q < 4; ++q) {
    float t = tot[q * 64 + kc];
    if (q < sq) prefix += t;
    blast += t;
  }
  unsigned vpk[8], kpk[8];
#pragma unroll
  for (int i = 0; i < 8; ++i) { vpk[i] = 0u; kpk[i] = 0u; }
#pragma unroll
  for (int i = 0; i < 16; ++i) {
    int s = sq * 16 + i;
    size_t tok = tok0 + s;
    float bcum = bc[i] + prefix;
    float kv = bf2f((u16)kraw[i]);
    vpk[i >> 1] |= vraw16[i] << (16 * (i & 1));
    if (OUT) {
      float qv = bf2f((u16)qraw[i]) * 0.125f;
      t0[s * 72 + kc] = f2bf(qv * __expf(bcum));
      t1[s * 72 + kc] = f2bf(kv * __expf(-bcum));
    } else {
      kpk[i >> 1] |= (unsigned)f2bf(kv * __expf(blast - bcum)) << (16 * (i & 1));
    }
  }
  *(uint4*)(t2 + kc * 72 + sq * 16) = make_uint4(vpk[0], vpk[1], vpk[2], vpk[3]);
  *(uint4*)(t2 + kc * 72 + sq * 16 + 8) = make_uint4(vpk[4], vpk[5], vpk[6], vpk[7]);
  if (!OUT) {
    *(uint4*)(t0 + kc * 72 + sq * 16) = make_uint4(kpk[0], kpk[1], kpk[2], kpk[3]);
    *(uint4*)(t0 + kc * 72 + sq * 16 + 8) = make_uint4(kpk[4], kpk[5], kpk[6], kpk[7]);
  }
  if (!OUT) {
    if (!p.dry) { if (sq == 0) ((float*)(p.ws + OFF_GDC))[((size_t)((b * 128 + c) * 4 + h)) * 64 + kc] = __expf(blast); }
  } else {
    *(uint4*)(t4 + (tid >> 3) * 72 + (tid & 7) * 8) = spv0;
    *(uint4*)(t4 + ((tid + 256) >> 3) * 72 + (tid & 7) * 8) = spv1;
  }
  __syncthreads();
  f32x4 acc[4];
#pragma unroll
  for (int n = 0; n < 4; ++n) acc[n] = f32x4{0.f, 0.f, 0.f, 0.f};
  if (!OUT) {
    mma_strip_t<4, 2>(t2 + (w * 16) * 72, 72, t0, 72, acc);
    if (!p.dry) {
#pragma unroll
      for (int n = 0; n < 4; ++n)
        *(uint2*)(gst + (w * 16 + fr) * 64 + n * 16 + fq * 4) = pack4(acc[n][0], acc[n][1], acc[n][2], acc[n][3]);
    }
    return;
  }
  const int lrow = w * 16 + fr;
  mma_strip_t<4, 2>(t0 + (w * 16) * 72, 72, t1, 72, acc);
#pragma unroll
  for (int n = 0; n < 4; ++n) {
    const int sb = n * 16 + fq * 4;
    *(uint2*)(t3 + lrow * 72 + sb) = pack4(sb <= lrow ? acc[n][0] : 0.f, sb + 1 <= lrow ? acc[n][1] : 0.f,
                                           sb + 2 <= lrow ? acc[n][2] : 0.f, sb + 3 <= lrow ? acc[n][3] : 0.f);
  }
  __syncthreads();
  f32x4 o[4];
#pragma unroll
  for (int n = 0; n < 4; ++n) o[n] = f32x4{0.f, 0.f, 0.f, 0.f};
  mma_strip_t<4, 2>(t3 + (w * 16) * 72, 72, t2, 72, o);
  mma_strip_t<4, 2>(t0 + (w * 16) * 72, 72, t4, 72, o);
  const float* nw = p.in[I_GLA_NW] + l * 256 + h * 64;
  float ss = 0.f;
#pragma unroll
  for (int n = 0; n < 4; ++n)
#pragma unroll
    for (int j = 0; j < 4; ++j) ss += o[n][j] * o[n][j];
  ss += __shfl_xor(ss, 16, 64);
  ss += __shfl_xor(ss, 32, 64);
  const float sc = rsqrtf(ss * (1.f / 64.f) + 1e-6f);
  const size_t tok = tok0 + lrow;
#pragma unroll
  for (int n = 0; n < 4; ++n) {
    const int v0 = n * 16 + fq * 4;
    uint2* gp = (uint2*)(P + tok * PC + h * 64 + v0);
    float g[4];
    unpack4(gq4[n], g);
    const float4 nv = *(const float4*)(nw + v0);
    if (!p.dry) *gp = pack4(o[n][0] * sc * nv.x * silu(g[0]), o[n][1] * sc * nv.y * silu(g[1]),
                            o[n][2] * sc * nv.z * silu(g[2]), o[n][3] * sc * nv.w * silu(g[3]));
  }
}

template <bool OUT>
__device__ __forceinline__ void ssd_item(const Params& p, int l, int b, int c, int h, unsigned char* smem) {
  u16* P = (u16*)(p.ws + OFF_P);
  const int tid = tidx(), lane = tid & 63, w = tid >> 6, fr = lane & 15, fq = lane >> 4;
  const int ch = lane, sq = w, g = h >> 1;
  u16* t0 = (u16*)smem;
  u16* t1 = t0 + 64 * 72;
  u16* t2 = t1 + 64 * 72;
  u16* t3 = t2 + 64 * 72;
  u16* t4 = t3 + 64 * 72;
  float* dts = (float*)(t4 + 64 * 72);
  float* acs = dts + 64;
  const size_t tok0 = (size_t)b * SEQ + c * 64;
  u16* sst = (u16*)(p.ws + OFF_SST) + ((size_t)((b * 128 + c) * 4 + h)) * 4096;
  __syncthreads();
  const int colx = C_XBC + h * 64 + ch, colb = C_XBC + 256 + g * 64 + ch, colc = C_XBC + 384 + g * 64 + ch;
  const int s0 = sq * 16;
  unsigned xr[19], br[19], cr[19];
#pragma unroll
  for (int j = 0; j < 19; ++j) {
    const int t = c * 64 + s0 - 3 + j;
    if (t >= 0) {
      const size_t tok = (size_t)b * SEQ + t;
      xr[j] = P[tok * PC + colx]; br[j] = P[tok * PC + colb]; cr[j] = P[tok * PC + colc];
    } else { xr[j] = 0u; br[j] = 0u; cr[j] = 0u; }
  }
  uint4 spv0 = make_uint4(0, 0, 0, 0), spv1 = spv0;
  uint2 gq4[4];
  if (OUT) {
    spv0 = *(const uint4*)(sst + tid * 8);
    spv1 = *(const uint4*)(sst + (tid + 256) * 8);
#pragma unroll
    for (int n = 0; n < 4; ++n) gq4[n] = *(const uint2*)(P + (tok0 + w * 16 + fr) * PC + 256 + h * 64 + n * 16 + fq * 4);
  }
  if (tid < 64) {
    float raw = bf2f(P[(tok0 + tid) * PC + C_DT + h]) + p.in[I_SSD_DTB][l * 4 + h];
    const float dtv = softplus(raw);
    dts[tid] = dtv;
    float x = dtv * -expf(p.in[I_SSD_ALOG][l * 4 + h]);
#pragma unroll
    for (int d = 1; d < 64; d <<= 1) {
      const float y = __shfl_up(x, d, 64);
      if (lane >= d) x += y;
    }
    acs[tid] = x;
  }
  __syncthreads();
  const float alast = acs[63];
  const int cix = h * 64 + ch, cib = 256 + g * 64 + ch, cic = 384 + g * 64 + ch;
  const float* cw = p.in[I_SSD_CW] + (size_t)l * 4 * 512;
  const float* cb = p.in[I_SSD_CB] + l * 512;
  float wx[4], wb[4], wcc[4];
#pragma unroll
  for (int j = 0; j < 4; ++j) { wx[j] = cw[j * 512 + cix]; wb[j] = cw[j * 512 + cib]; wcc[j] = cw[j * 512 + cic]; }
  const float bx = cb[cix], bb = cb[cib], bcv = cb[cic];
  float hx[3], hb[3], hc[3];
  unsigned pk0[8], pk1[8];
#pragma unroll
  for (int i = 0; i < 8; ++i) { pk0[i] = 0u; pk1[i] = 0u; }
#pragma unroll
  for (int j = 0; j < 3; ++j) { hx[j] = bf2f((u16)xr[j]); hb[j] = bf2f((u16)br[j]); hc[j] = bf2f((u16)cr[j]); }
#pragma unroll
  for (int i = 0; i < 16; ++i) {
    int s = s0 + i;
    float cx = bf2f((u16)xr[i + 3]), cbv = bf2f((u16)br[i + 3]), ccv = bf2f((u16)cr[i + 3]);
    float xs = silu(wx[0] * hx[0] + wx[1] * hx[1] + wx[2] * hx[2] + wx[3] * cx + bx);
    float bm = silu(wb[0] * hb[0] + wb[1] * hb[1] + wb[2] * hb[2] + wb[3] * cbv + bb);
    float cm = silu(wcc[0] * hc[0] + wcc[1] * hc[1] + wcc[2] * hc[2] + wcc[3] * ccv + bcv);
    hx[0] = hx[1]; hx[1] = hx[2]; hx[2] = cx;
    hb[0] = hb[1]; hb[1] = hb[2]; hb[2] = cbv;
    hc[0] = hc[1]; hc[1] = hc[2]; hc[2] = ccv;
    float dt = dts[s];
    if (OUT) {
      t0[s * 72 + ch] = f2bf(cm);
      t1[s * 72 + ch] = f2bf(bm);
      pk0[i >> 1] |= (unsigned)f2bf(xs * dt) << (16 * (i & 1));
      t4[s * 72 + ch] = f2bf(xs);
    } else {
      pk0[i >> 1] |= (unsigned)f2bf(bm) << (16 * (i & 1));
      pk1[i >> 1] |= (unsigned)f2bf(xs * dt * __expf(alast - acs[s])) << (16 * (i & 1));
    }
  }
  if (OUT) {
    *(uint4*)(t2 + ch * 72 + s0) = make_uint4(pk0[0], pk0[1], pk0[2], pk0[3]);
    *(uint4*)(t2 + ch * 72 + s0 + 8) = make_uint4(pk0[4], pk0[5], pk0[6], pk0[7]);
  } else {
    *(uint4*)(t0 + ch * 72 + s0) = make_uint4(pk0[0], pk0[1], pk0[2], pk0[3]);
    *(uint4*)(t0 + ch * 72 + s0 + 8) = make_uint4(pk0[4], pk0[5], pk0[6], pk0[7]);
    *(uint4*)(t1 + ch * 72 + s0) = make_uint4(pk1[0], pk1[1], pk1[2], pk1[3]);
    *(uint4*)(t1 + ch * 72 + s0 + 8) = make_uint4(pk1[4], pk1[5], pk1[6], pk1[7]);
  }
  if (!OUT) {
    if (!p.dry) { if (sq == 0) ((float*)(p.ws + OFF_SDC))[((size_t)((b * 128 + c) * 4 + h)) * 64 + ch] = __expf(alast); }
  } else {
    *(uint4*)(t3 + (tid >> 3) * 72 + (tid & 7) * 8) = spv0;
    *(uint4*)(t3 + ((tid + 256) >> 3) * 72 + (tid & 7) * 8) = spv1;
  }
  __syncthreads();
  f32x4 acc[4];
#pragma unroll
  for (int n = 0; n < 4; ++n) acc[n] = f32x4{0.f, 0.f, 0.f, 0.f};
  if (!OUT) {
    mma_strip_t<4, 2>(t1 + (w * 16) * 72, 72, t0, 72, acc);
    if (!p.dry) {
#pragma unroll
      for (int n = 0; n < 4; ++n)
        *(uint2*)(sst + (w * 16 + fr) * 64 + n * 16 + fq * 4) = pack4(acc[n][0], acc[n][1], acc[n][2], acc[n][3]);
    }
    return;
  }
  const int lrow = w * 16 + fr;
  mma_strip_t<4, 2>(t0 + (w * 16) * 72, 72, t1, 72, acc);
  __syncthreads();
  {
    const float al = acs[lrow];
#pragma unroll
    for (int n = 0; n < 4; ++n) {
      const int sb = n * 16 + fq * 4;
      float v[4];
#pragma unroll
      for (int j = 0; j < 4; ++j) v[j] = (sb + j <= lrow) ? acc[n][j] * __expf(al - acs[sb + j]) : 0.f;
      *(uint2*)(t1 + lrow * 72 + sb) = pack4(v[0], v[1], v[2], v[3]);
    }
  }
  __syncthreads();
  f32x4 y[4], yi[4];
#pragma unroll
  for (int n = 0; n < 4; ++n) { y[n] = f32x4{0.f, 0.f, 0.f, 0.f}; yi[n] = f32x4{0.f, 0.f, 0.f, 0.f}; }
  mma_strip_t<4, 2>(t1 + (w * 16) * 72, 72, t2, 72, y);
  mma_strip_t<4, 2>(t0 + (w * 16) * 72, 72, t3, 72, yi);
  const float Dh = p.in[I_SSD_D][l * 4 + h];
  const float* nw = p.in[I_SSD_NW] + l * 256 + h * 64;
  const float ea = __expf(acs[lrow]);
  float vals[4][4];
  float ss = 0.f;
#pragma unroll
  for (int n = 0; n < 4; ++n) {
    float xv[4];
    unpack4(*(const uint2*)(t4 + lrow * 72 + n * 16 + fq * 4), xv);
#pragma unroll
    for (int j = 0; j < 4; ++j) {
      float v = y[n][j] + yi[n][j] * ea + Dh * xv[j];
      vals[n][j] = v;
      ss += v * v;
    }
  }
  ss += __shfl_xor(ss, 16, 64);
  ss += __shfl_xor(ss, 32, 64);
  const float sc = rsqrtf(ss * (1.f / 64.f) + 1e-6f);
  const size_t tok = tok0 + lrow;
#pragma unroll
  for (int n = 0; n < 4; ++n) {
    const int p0 = n * 16 + fq * 4;
    uint2* gp = (uint2*)(P + tok * PC + 256 + h * 64 + p0);
    float g[4];
    unpack4(gq4[n], g);
    const float4 nv = *(const float4*)(nw + p0);
    if (!p.dry) *gp = pack4(vals[n][0] * sc * nv.x * silu(g[0]), vals[n][1] * sc * nv.y * silu(g[1]),
                            vals[n][2] * sc * nv.z * silu(g[2]), vals[n][3] * sc * nv.w * silu(g[3]));
  }
}

__device__ __forceinline__ void state_scan_item(const Params& p, u16* st, const float* dc, int item) {
  const int tid = tidx();
  const int bh = item >> 3, b = bh >> 2, h = bh & 3;
  const int e = ((item & 7) * 256 + tid) * 2;
  float s0 = 0.f, s1 = 0.f;
#pragma unroll 1
  for (int c0 = 0; c0 < 128; c0 += 8) {
    unsigned cv[8];
    float2 dv[8];
#pragma unroll
    for (int i = 0; i < 8; ++i) {
      size_t base = (size_t)((b * 128 + c0 + i) * 4 + h);
      cv[i] = *(const unsigned*)(st + base * 4096 + e);
      dv[i] = *(const float2*)(dc + base * 64 + (e & 63));
    }
#pragma unroll
    for (int i = 0; i < 8; ++i) {
      size_t base = (size_t)((b * 128 + c0 + i) * 4 + h);
      if (!p.dry) { *(unsigned*)(st + base * 4096 + e) = (unsigned)f2bf(s0) | ((unsigned)f2bf(s1) << 16); }
      s0 = dv[i].x * s0 + __uint_as_float(cv[i] << 16);
      s1 = dv[i].y * s1 + __uint_as_float(cv[i] & 0xffff0000u);
    }
  }
}

template <bool OUT>
__device__ __forceinline__ void s5_item(const Params& p, int l, int b, int c, unsigned char* smem) {
  u16* P = (u16*)(p.ws + OFF_P);
  const int tid = tidx(), lane = tid & 63, w = tid >> 6, fr = lane & 15, fq = lane >> 4;
  float* Bu = (float*)smem + w * (16 * 132);
  const size_t tok0 = (size_t)b * SEQ + c * 64;
  __syncthreads();
  for (int gi = 0; gi < 4; ++gi) {
    const int g = gi * 4 + w;
    const float* Ab = (const float*)(p.ws + OFF_S5A) + ((size_t)(l * 16 + g) * 64) * 2;
    const u16* Bb = (const u16*)(p.ws + OFF_S5B) + (size_t)(l * 16 + g) * 128 * 32;
    const u16* Cm = (const u16*)(p.ws + OFF_S5C) + (size_t)(l * 16 + g) * 16 * 128;
    float* xs = (float*)(p.ws + OFF_S5X) + (((size_t)(b * 128 + c) * 16 + g) * 64) * 2;
    const float ar = Ab[lane * 2], ai = Ab[lane * 2 + 1];
    float xr = 0.f, xi = 0.f;
    if (OUT) { xr = xs[lane * 2]; xi = xs[lane * 2 + 1]; }
    const float Dv = p.in[I_S5_D][l * 256 + g * 16 + fr];
    for (int mt = 0; mt < 4; ++mt) {
      bf16x8 a = bf16x8{0, 0, 0, 0, 0, 0, 0, 0};
      if (fq < 2) a = *(const bf16x8*)(P + (tok0 + mt * 16 + fr) * PC + C_S5U + g * 16 + fq * 8);
#pragma unroll
      for (int nt = 0; nt < 8; ++nt) {
        bf16x8 bb = *(const bf16x8*)(Bb + (nt * 16 + fr) * 32 + fq * 8);
        f32x4 r = __builtin_amdgcn_mfma_f32_16x16x32_bf16(a, bb, f32x4{0.f, 0.f, 0.f, 0.f}, 0, 0, 0);
#pragma unroll
        for (int j = 0; j < 4; ++j) Bu[(fq * 4 + j) * 132 + nt * 16 + fr] = r[j];
      }
      __syncthreads();
      for (int t = 0; t < 16; ++t) {
        float bre = Bu[t * 132 + lane], bim = Bu[t * 132 + 64 + lane];
        float nr = ar * xr - ai * xi + bre;
        float ni = ar * xi + ai * xr + bim;
        xr = nr; xi = ni;
        if (OUT) {
          u16* X = (u16*)(Bu + t * 132);
          X[lane] = f2bf(xr);
          X[64 + lane] = f2bf(xi);
        }
      }
      __syncthreads();
      if (OUT) {
        f32x4 ya[1];
        ya[0] = f32x4{0.f, 0.f, 0.f, 0.f};
        mma_strip<1, 4>((const u16*)Bu, 264, Cm, 128, ya);
#pragma unroll
        for (int j = 0; j < 4; ++j) {
          size_t a_ = (tok0 + mt * 16 + fq * 4 + j) * PC + C_S5U + g * 16 + fr;
          float uval = bf2f(P[a_]);
          float yv = ya[0][j] + Dv * uval;
          if (!p.dry) { P[a_] = f2bf(gelu_tanh(yv)); }
        }
        __syncthreads();
      }
    }
    if (!p.dry) { if (!OUT) { xs[lane * 2] = xr; xs[lane * 2 + 1] = xi; } }
  }
}

__device__ __forceinline__ void s5_scan_item(const Params& p, int l, int item) {
  const int sidx = item * 256 + tidx();
  const int b = sidx >> 10, gp = sidx & 1023;
  const float* A64 = (const float*)(p.ws + OFF_S5A64) + ((size_t)l * 1024 + gp) * 2;
  const float ar = A64[0], ai = A64[1];
  float2* xs = (float2*)(p.ws + OFF_S5X);
  float xr = 0.f, xi = 0.f;
#pragma unroll 1
  for (int c0 = 0; c0 < 128; c0 += 8) {
    float2 v[8];
#pragma unroll
    for (int i = 0; i < 8; ++i) v[i] = xs[(size_t)(b * 128 + c0 + i) * 1024 + gp];
#pragma unroll
    for (int i = 0; i < 8; ++i) {
      if (!p.dry) { xs[(size_t)(b * 128 + c0 + i) * 1024 + gp] = make_float2(xr, xi); }
      float nr = ar * xr - ai * xi + v[i].x;
      float ni = ar * xi + ai * xr + v[i].y;
      xr = nr; xi = ni;
    }
  }
}

__device__ __forceinline__ void rwkv_prep_item(const Params& p, int l, int item, unsigned char* smem) {
  u16* P = (u16*)(p.ws + OFF_P);
  const int tid = tidx(), lane = tid & 63, w = tid >> 6, fr = lane & 15, fq = lane >> 4;
  u16* Aw = (u16*)smem;
  u16* Aa = Aw + 16 * 72;
  u16* Av = Aa + 16 * 72;
  u16* Awl = Av + 16 * 40;
  const size_t tok0 = (size_t)item * 16;
  const float* mu = p.in[I_RW_MU] + l * 896;
  __syncthreads();
  for (int idx = tid; idx < 160 * 16; idx += 256) {
    int t = idx / 160, j = idx % 160;
    size_t tok = tok0 + t;
    if (j < 128) {
      int col = C_RW + 768 + j;
      float cur = bf2f(P[tok * PC + col]);
      float prev = ((tok & (SEQ - 1)) != 0) ? bf2f(P[(tok - 1) * PC + col]) : 0.f;
      float val = cur + (prev - cur) * mu[768 + j];
      if (j < 64) {
        const float th = 1.f - 2.f / (1.f + __expf(2.f * val));
        const u16 hi = f2bf(th);
        Aw[t * 72 + j] = hi;
        Awl[t * 72 + j] = f2bf(th - bf2f(hi));
      }
      else Aa[t * 72 + j - 64] = f2bf(val);
    } else {
      Av[t * 40 + j - 128] = P[tok * PC + C_VL + j - 128];
    }
  }
  __syncthreads();
  f32x4 accw[4], acca[4], accv[4];
#pragma unroll
  for (int n = 0; n < 4; ++n) { accw[n] = f32x4{0.f, 0.f, 0.f, 0.f}; acca[n] = accw[n]; accv[n] = accw[n]; }
  mma_strip_t<4, 2>(Aw, 72, (const u16*)(p.ws + OFF_W2T) + ((size_t)l * 256 + w * 64) * 64, 64, accw);
  mma_strip_t<4, 2>(Awl, 72, (const u16*)(p.ws + OFF_W2T) + ((size_t)l * 256 + w * 64) * 64, 64, accw);
  mma_strip_t<4, 2>(Aw, 72, (const u16*)(p.ws + OFF_W2L) + ((size_t)l * 256 + w * 64) * 64, 64, accw);
  mma_strip_t<4, 2>(Aa, 72, (const u16*)(p.ws + OFF_A2T) + ((size_t)l * 256 + w * 64) * 64, 64, acca);
  if (l > 0) mma_strip_t<4, 1>(Av, 40, (const u16*)(p.ws + OFF_V2T) + ((size_t)(l - 1) * 256 + w * 64) * 32, 32, accv);
  u16* R = (u16*)(p.ws + OFF_PREP);
  u16* Kp = R + (size_t)NTOK * 256;
  u16* V = Kp + (size_t)NTOK * 256;
  u16* KK = V + (size_t)NTOK * 256;
  u16* BV = KK + (size_t)NTOK * 256;
  u16* LW = BV + (size_t)NTOK * 256;
  u16* VF = (u16*)(p.ws + OFF_VF);
  const size_t tok = tok0 + fr;
  const bool hasprev = (tok & (SEQ - 1)) != 0;
  float kkv[4][4], av[4][4], kx[4][4];
  float ss = 0.f;
#pragma unroll
  for (int n = 0; n < 4; ++n) {
    const int cb = w * 64 + n * 16 + fq * 4;
    float kc_[4], kp_[4] = {0.f, 0.f, 0.f, 0.f};
    unpack4(*(const uint2*)(P + tok * PC + C_RW + 256 + cb), kc_);
    if (hasprev) unpack4(*(const uint2*)(P + (tok - 1) * PC + C_RW + 256 + cb), kp_);
    const float4 muk = *(const float4*)(mu + 256 + cb);
    const float4 kkw = *(const float4*)(p.in[I_RW_KK] + l * 256 + cb);
    const float4 a0 = *(const float4*)(p.in[I_RW_A0] + l * 256 + cb);
    const float mk[4] = {muk.x, muk.y, muk.z, muk.w}, kw[4] = {kkw.x, kkw.y, kkw.z, kkw.w}, a0v[4] = {a0.x, a0.y, a0.z, a0.w};
#pragma unroll
    for (int j = 0; j < 4; ++j) {
      const float k = kc_[j] + (kp_[j] - kc_[j]) * mk[j];
      kx[n][j] = k;
      const float kk = k * kw[j];
      kkv[n][j] = kk;
      ss += kk * kk;
      av[n][j] = sigm(a0v[j] + acca[n][j]);
    }
  }
  ss += __shfl_xor(ss, 16, 64);
  ss += __shfl_xor(ss, 32, 64);
  const float kn = rsqrtf(ss + 1e-12f);
#pragma unroll
  for (int n = 0; n < 4; ++n) {
    const int cb = w * 64 + n * 16 + fq * 4;
    float rc[4], rp[4] = {0.f, 0.f, 0.f, 0.f}, vc[4], vp[4] = {0.f, 0.f, 0.f, 0.f};
    unpack4(*(const uint2*)(P + tok * PC + C_RW + cb), rc);
    unpack4(*(const uint2*)(P + tok * PC + C_RW + 512 + cb), vc);
    if (hasprev) {
      unpack4(*(const uint2*)(P + (tok - 1) * PC + C_RW + cb), rp);
      unpack4(*(const uint2*)(P + (tok - 1) * PC + C_RW + 512 + cb), vp);
    }
    const float4 mur = *(const float4*)(mu + cb);
    const float4 muv = *(const float4*)(mu + 512 + cb);
    const float4 w0 = *(const float4*)(p.in[I_RW_W0] + l * 256 + cb);
    const float4 kaw = *(const float4*)(p.in[I_RW_KA] + l * 256 + cb);
    const float mr[4] = {mur.x, mur.y, mur.z, mur.w}, mv[4] = {muv.x, muv.y, muv.z, muv.w};
    const float w0v[4] = {w0.x, w0.y, w0.z, w0.w}, kav[4] = {kaw.x, kaw.y, kaw.z, kaw.w};
    float vfv[4] = {0.f, 0.f, 0.f, 0.f}, v0v[4] = {0.f, 0.f, 0.f, 0.f};
    if (l > 0) {
      unpack4(*(const uint2*)(VF + tok * 256 + cb), vfv);
      const float4 v0 = *(const float4*)(p.in[I_RW_V0] + (l - 1) * 256 + cb);
      v0v[0] = v0.x; v0v[1] = v0.y; v0v[2] = v0.z; v0v[3] = v0.w;
    }
    float ro[4], ko[4], vo[4], kko[4], bo[4], lo[4];
#pragma unroll
    for (int j = 0; j < 4; ++j) {
      ro[j] = rc[j] + (rp[j] - rc[j]) * mr[j];
      float v = vc[j] + (vp[j] - vc[j]) * mv[j];
      if (l > 0) v = v + (vfv[j] - v) * sigm(v0v[j] + accv[n][j]);
      vo[j] = v;
      const float wraw = -softplus(-(w0v[j] + accw[n][j])) - 0.5f;
      lo[j] = -__expf(wraw);
      const float a = av[n][j];
      const float kk = kkv[n][j] * kn;
      kko[j] = kk;
      bo[j] = kk * a;
      ko[j] = kx[n][j] * (1.f + (a - 1.f) * kav[j]);
    }
    if (!p.dry) {
      const size_t o = tok * 256 + cb;
      if (l == 0) *(uint2*)(VF + o) = pack4(vo[0], vo[1], vo[2], vo[3]);
      *(uint2*)(R + o) = pack4(ro[0], ro[1], ro[2], ro[3]);
      *(uint2*)(Kp + o) = pack4(ko[0], ko[1], ko[2], ko[3]);
      *(uint2*)(V + o) = pack4(vo[0], vo[1], vo[2], vo[3]);
      *(uint2*)(KK + o) = pack4(kko[0], kko[1], kko[2], kko[3]);
      *(uint2*)(BV + o) = pack4(bo[0], bo[1], bo[2], bo[3]);
      *(uint2*)(LW + o) = pack4(lo[0], lo[1], lo[2], lo[3]);
    }
  }
}

typedef float f2 __attribute__((ext_vector_type(2)));
__device__ __forceinline__ float dpp_xor1(float v) { return __int_as_float(__builtin_amdgcn_update_dpp(0, __float_as_int(v), 0xB1, 0xf, 0xf, false)); }
__device__ __forceinline__ float dpp_xor2(float v) { return __int_as_float(__builtin_amdgcn_update_dpp(0, __float_as_int(v), 0x4E, 0xf, 0xf, false)); }
__device__ __forceinline__ void unpack8(const uint4& u, float* o) {
  o[0] = __uint_as_float(u.x << 16); o[1] = __uint_as_float(u.x & 0xffff0000u);
  o[2] = __uint_as_float(u.y << 16); o[3] = __uint_as_float(u.y & 0xffff0000u);
  o[4] = __uint_as_float(u.z << 16); o[5] = __uint_as_float(u.z & 0xffff0000u);
  o[6] = __uint_as_float(u.w << 16); o[7] = __uint_as_float(u.w & 0xffff0000u);
}
__device__ __forceinline__ void stage8(float* dst, const uint4& u, bool do_exp) {
  float o[8];
  unpack8(u, o);
  if (do_exp) {
#pragma unroll
    for (int i = 0; i < 8; ++i) o[i] = __expf(o[i]);
  }
  ((float4*)dst)[0] = make_float4(o[0], o[1], o[2], o[3]);
  ((float4*)dst)[1] = make_float4(o[4], o[5], o[6], o[7]);
}
template <int PASS, bool USEV>
__device__ __forceinline__ void rwkv_scan_wave(const Params& p, int l, int wi, float* lds) {
  u16* P = (u16*)(p.ws + OFF_P);
  const int lane = tidx() & 63, rg = lane >> 2, q = lane & 3;
  int which = 0, seg, bh;
  if (PASS == 1) { which = wi & 1; seg = (wi >> 1) % NSEG; bh = (wi >> 1) / NSEG; }
  else { seg = wi % NSEG; bh = wi / NSEG; }
  const int b = bh >> 2, h = bh & 3;
  float* sw = lds;
  float* skk = sw + 512;
  float* sb = skk + 512;
  float* sk = sb + 512;
  float* sv = sk + 512;
  float* sr = sv + 512;
  float* sy = sw;
  const u16* R = (const u16*)(p.ws + OFF_PREP);
  const u16* Kp = R + (size_t)NTOK * 256;
  const u16* V = Kp + (size_t)NTOK * 256;
  const u16* KK = V + (size_t)NTOK * 256;
  const u16* BV = KK + (size_t)NTOK * 256;
  const u16* LW = BV + (size_t)NTOK * 256;
  float* Sl = (float*)(p.ws + OFF_RSL) + ((size_t)(bh * NSEG + seg)) * 4096;
  float* Pm = (float*)(p.ws + OFF_RPM) + ((size_t)(bh * NSEG + seg)) * 4096;
  f2 e[4][8];
  if (PASS == 1) {
#pragma unroll
    for (int r = 0; r < 4; ++r)
#pragma unroll
      for (int j = 0; j < 8; ++j) {
        int row = rg * 4 + r, c0 = q * 16 + j * 2;
        e[r][j] = f2{(which == 1 && row == c0) ? 1.f : 0.f, (which == 1 && row == c0 + 1) ? 1.f : 0.f};
      }
  } else {
#pragma unroll
    for (int r = 0; r < 4; ++r)
#pragma unroll
      for (int i = 0; i < 4; ++i) {
        float4 v = *(const float4*)(Sl + (rg * 4 + r) * 64 + q * 16 + i * 4);
        e[r][i * 2] = f2{v.x, v.y};
        e[r][i * 2 + 1] = f2{v.z, v.w};
      }
  }
  constexpr bool usev = USEV;
  const int st = lane >> 3, sc8 = (lane & 7) * 8;
  const size_t g0 = ((size_t)b * SEQ + (size_t)seg * SEGLEN) * 256 + h * 64 + (size_t)st * 256 + sc8;
  float rkw[8], gnw[8], gnb[8];
  if (PASS == 3) {
#pragma unroll
    for (int i = 0; i < 8; ++i) {
      rkw[i] = p.in[I_RW_RK][l * 256 + h * 64 + sc8 + i];
      gnw[i] = p.in[I_RW_GNW][l * 256 + h * 64 + sc8 + i];
      gnb[i] = p.in[I_RW_GNB][l * 256 + h * 64 + sc8 + i];
    }
  }
  uint4 nlw, nkk, nb, nk, nv, nr;
  nv = make_uint4(0, 0, 0, 0);
  nr = nv;
#define RW_ISSUE(sc)                                              \
  {                                                               \
    const size_t gi = g0 + (size_t)(sc) * 8 * 256;                \
    nlw = *(const uint4*)(LW + gi);                               \
    nkk = *(const uint4*)(KK + gi);                               \
    nb = *(const uint4*)(BV + gi);                                \
    nk = *(const uint4*)(Kp + gi);                                \
    if (usev) nv = *(const uint4*)(V + gi);                       \
    if (PASS == 3) nr = *(const uint4*)(R + gi);                  \
  }
  RW_ISSUE(0);
#pragma unroll 1
  for (int sc = 0; sc < SEGLEN / 8; ++sc) {
    asm volatile("" ::: "memory");
    stage8(sw + st * 64 + sc8, nlw, true);
    stage8(skk + st * 64 + sc8, nkk, false);
    stage8(sb + st * 64 + sc8, nb, false);
    stage8(sk + st * 64 + sc8, nk, false);
    stage8(sv + st * 64 + sc8, nv, false);
    if (PASS == 3) stage8(sr + st * 64 + sc8, nr, false);
    if (sc + 1 < SEGLEN / 8) RW_ISSUE(sc + 1);
    __builtin_amdgcn_wave_barrier();
    asm volatile("" ::: "memory");
#pragma unroll 2
    for (int t = 0; t < 8; ++t) {
      f2 kk2[8], w2[8], b2[8], k2[8];
#pragma unroll
      for (int i = 0; i < 4; ++i) {
        float4 a = ((const float4*)(skk + t * 64 + q * 16))[i];
        kk2[i * 2] = f2{a.x, a.y}; kk2[i * 2 + 1] = f2{a.z, a.w};
        float4 c = ((const float4*)(sw + t * 64 + q * 16))[i];
        w2[i * 2] = f2{c.x, c.y}; w2[i * 2 + 1] = f2{c.z, c.w};
        float4 d = ((const float4*)(sb + t * 64 + q * 16))[i];
        b2[i * 2] = f2{d.x, d.y}; b2[i * 2 + 1] = f2{d.z, d.w};
        float4 g = ((const float4*)(sk + t * 64 + q * 16))[i];
        k2[i * 2] = f2{g.x, g.y}; k2[i * 2 + 1] = f2{g.z, g.w};
      }
      const float4 vv4 = *(const float4*)(sv + t * 64 + rg * 4);
      const float vvr[4] = {vv4.x, vv4.y, vv4.z, vv4.w};
      float sa[4];
#pragma unroll
      for (int r = 0; r < 4; ++r) {
        f2 acc = e[r][0] * kk2[0];
#pragma unroll
        for (int j = 1; j < 8; ++j) acc = e[r][j] * kk2[j] + acc;
        float part = acc.x + acc.y;
        part += dpp_xor1(part);
        part += dpp_xor2(part);
        sa[r] = -part;
      }
#pragma unroll
      for (int r = 0; r < 4; ++r) {
        const f2 sa2 = f2{sa[r], sa[r]};
        const f2 vv2 = f2{vvr[r], vvr[r]};
#pragma unroll
        for (int j = 0; j < 8; ++j) {
          f2 tnew = e[r][j] * w2[j];
          tnew = sa2 * b2[j] + tnew;
          if (USEV) tnew = vv2 * k2[j] + tnew;
          e[r][j] = tnew;
        }
      }
      if (PASS == 3) {
        f2 r2[8];
#pragma unroll
        for (int i = 0; i < 4; ++i) {
          float4 a = ((const float4*)(sr + t * 64 + q * 16))[i];
          r2[i * 2] = f2{a.x, a.y}; r2[i * 2 + 1] = f2{a.z, a.w};
        }
        float yv[4];
#pragma unroll
        for (int r = 0; r < 4; ++r) {
          f2 acc = e[r][0] * r2[0];
#pragma unroll
          for (int j = 1; j < 8; ++j) acc = e[r][j] * r2[j] + acc;
          float part = acc.x + acc.y;
          part += dpp_xor1(part);
          part += dpp_xor2(part);
          yv[r] = part;
        }
        if (q == 0) *(float4*)(sy + t * 64 + rg * 4) = make_float4(yv[0], yv[1], yv[2], yv[3]);
      }
    }
    if (PASS == 3) {
      __builtin_amdgcn_wave_barrier();
      asm volatile("" ::: "memory");
      float yv[8], rr[8], kx[8], vx[8];
#pragma unroll
      for (int i = 0; i < 2; ++i) {
        float4 a = ((const float4*)(sy + st * 64 + sc8))[i];
        yv[i * 4] = a.x; yv[i * 4 + 1] = a.y; yv[i * 4 + 2] = a.z; yv[i * 4 + 3] = a.w;
        float4 c = ((const float4*)(sr + st * 64 + sc8))[i];
        rr[i * 4] = c.x; rr[i * 4 + 1] = c.y; rr[i * 4 + 2] = c.z; rr[i * 4 + 3] = c.w;
        float4 d = ((const float4*)(sk + st * 64 + sc8))[i];
        kx[i * 4] = d.x; kx[i * 4 + 1] = d.y; kx[i * 4 + 2] = d.z; kx[i * 4 + 3] = d.w;
        float4 g = ((const float4*)(sv + st * 64 + sc8))[i];
        vx[i * 4] = g.x; vx[i * 4 + 1] = g.y; vx[i * 4 + 2] = g.z; vx[i * 4 + 3] = g.w;
      }
      float s1 = 0.f, bon = 0.f;
#pragma unroll
      for (int i = 0; i < 8; ++i) { s1 += yv[i]; bon += rr[i] * kx[i] * rkw[i]; }
#pragma unroll
      for (int m = 4; m >= 1; m >>= 1) { s1 += __shfl_xor(s1, m, 64); bon += __shfl_xor(bon, m, 64); }
      const float mean = s1 * (1.f / 64.f);
      float s2 = 0.f;
#pragma unroll
      for (int i = 0; i < 8; ++i) { float d = yv[i] - mean; s2 += d * d; }
#pragma unroll
      for (int m = 4; m >= 1; m >>= 1) s2 += __shfl_xor(s2, m, 64);
      const float rs = rsqrtf(s2 * (1.f / 64.f) + 64e-5f);
      const size_t tok = (size_t)b * SEQ + (size_t)seg * SEGLEN + sc * 8 + st;
      uint4* gp = (uint4*)(P + tok * PC + 768 + h * 64 + sc8);
      uint4 gq = *gp;
      float gt[8];
      unpack8(gq, gt);
      unsigned ow[4];
#pragma unroll
      for (int i = 0; i < 4; ++i) {
        float o0 = ((yv[2 * i] - mean) * rs * gnw[2 * i] + gnb[2 * i] + bon * vx[2 * i]) * silu(gt[2 * i]);
        float o1 = ((yv[2 * i + 1] - mean) * rs * gnw[2 * i + 1] + gnb[2 * i + 1] + bon * vx[2 * i + 1]) * silu(gt[2 * i + 1]);
        ow[i] = (unsigned)f2bf(o0) | ((unsigned)f2bf(o1) << 16);
      }
      if (!p.dry) *gp = make_uint4(ow[0], ow[1], ow[2], ow[3]);
    }
  }
#undef RW_ISSUE
  if (PASS == 1) {
    float* dst = (which == 0) ? Sl : Pm;
    if (!p.dry) {
#pragma unroll
      for (int r = 0; r < 4; ++r)
#pragma unroll
        for (int i = 0; i < 4; ++i)
          *(float4*)(dst + (rg * 4 + r) * 64 + q * 16 + i * 4) = make_float4(e[r][i * 2].x, e[r][i * 2].y, e[r][i * 2 + 1].x, e[r][i * 2 + 1].y);
    }
  }
}

__device__ __forceinline__ void rwkv_chain_item(const Params& p, int item, unsigned char* smem) {
  const int tid = tidx();
  const int bh = item >> 2, rg = item & 3;
  const int lr = tid >> 4, row = rg * 16 + lr, cq = tid & 15;
  float* srow = (float*)smem;
  float* sP = srow + 1024;
  float* SlB = (float*)(p.ws + OFF_RSL) + ((size_t)(bh * NSEG)) * 4096;
  const float* PmB = (const float*)(p.ws + OFF_RPM) + ((size_t)(bh * NSEG)) * 4096;
  float4 cur = make_float4(0.f, 0.f, 0.f, 0.f);
  float4 a0, a1, a2, a3, al, b0, b1, b2, b3, bl, c0, c1, c2, c3, cl, d0, d1, d2, d3, dl;
#define CH_LOAD(X, sg)                                                         \
  {                                                                            \
    const float4* nP = (const float4*)(PmB + (size_t)(sg) * 4096);             \
    X##0 = nP[tid]; X##1 = nP[tid + 256]; X##2 = nP[tid + 512]; X##3 = nP[tid + 768]; \
    X##l = *(const float4*)(SlB + (size_t)(sg) * 4096 + row * 64 + cq * 4);    \
  }
#define CH_STEP(X, Y, sg)                                                      \
  {                                                                            \
    ((float4*)sP)[tid] = X##0; ((float4*)sP)[tid + 256] = X##1;                \
    ((float4*)sP)[tid + 512] = X##2; ((float4*)sP)[tid + 768] = X##3;          \
    *(float4*)(srow + lr * 64 + cq * 4) = cur;                                 \
    float4 nx = X##l;                                                          \
    __syncthreads();                                                           \
    if (!p.dry) { *(float4*)(SlB + (size_t)(sg) * 4096 + row * 64 + cq * 4) = cur; } \
    if ((sg) + 3 < NSEG) CH_LOAD(Y, (sg) + 3);                                 \
    _Pragma("unroll 16") for (int j = 0; j < 64; ++j) {                        \
      float sv_ = srow[lr * 64 + j];                                           \
      float4 pm = *(const float4*)(sP + j * 64 + cq * 4);                      \
      nx.x += sv_ * pm.x; nx.y += sv_ * pm.y; nx.z += sv_ * pm.z; nx.w += sv_ * pm.w; \
    }                                                                          \
    __syncthreads();                                                           \
    cur = nx;                                                                  \
  }
  CH_LOAD(a, 0);
  CH_LOAD(b, 1);
  CH_LOAD(c, 2);
  d0 = d1 = d2 = d3 = dl = cur;
  __syncthreads();
#pragma unroll 1
  for (int seg = 0; seg < NSEG; seg += 4) {
    CH_STEP(a, d, seg);
    CH_STEP(b, a, seg + 1);
    CH_STEP(c, b, seg + 2);
    CH_STEP(d, c, seg + 3);
  }
#undef CH_LOAD
#undef CH_STEP
}

__device__ __forceinline__ void memattn_item(const Params& p, int l, int b, int h, int tile, unsigned char* smem) {
  u16* P = (u16*)(p.ws + OFF_P);
  const int tid = tidx(), lane = tid & 63, w = tid >> 6, fr = lane & 15, fq = lane >> 4;
  u16* pw = (u16*)smem + w * (16 * 264);
  const u16* km = (const u16*)(p.ws + OFF_KM) + (size_t)l * 1024 * 256 + (size_t)b * 256 * 256 + h * 64;
  const u16* vmT = (const u16*)(p.ws + OFF_VMT) + (size_t)l * 4 * 256 * 256 + ((size_t)b * 256 + h * 64) * 256;
  const size_t tok0 = (size_t)b * SEQ + tile * 64 + w * 16;
  __syncthreads();
  f32x4 acc[16];
#pragma unroll
  for (int n = 0; n < 16; ++n) acc[n] = f32x4{0.f, 0.f, 0.f, 0.f};
  {
    const u16* Aq = P + tok0 * PC + C_MQ + h * 64;
    bf16x8 a0 = *(const bf16x8*)(Aq + fr * PC + fq * 8);
    bf16x8 a1 = *(const bf16x8*)(Aq + fr * PC + 32 + fq * 8);
#pragma unroll
    for (int n4 = 0; n4 < 4; ++n4) {
#pragma unroll
      for (int nn = 0; nn < 4; ++nn) {
        int n = n4 * 4 + nn;
        bf16x8 b0 = *(const bf16x8*)(km + (n * 16 + fr) * 256 + fq * 8);
        bf16x8 b1 = *(const bf16x8*)(km + (n * 16 + fr) * 256 + 32 + fq * 8);
        acc[n] = __builtin_amdgcn_mfma_f32_16x16x32_bf16(b0, a0, acc[n], 0, 0, 0);
        acc[n] = __builtin_amdgcn_mfma_f32_16x16x32_bf16(b1, a1, acc[n], 0, 0, 0);
      }
      __builtin_amdgcn_sched_barrier(0);
    }
  }
  {
    float mx = -1e30f;
#pragma unroll
    for (int n = 0; n < 16; ++n)
#pragma unroll
      for (int j = 0; j < 4; ++j) mx = fmaxf(mx, acc[n][j]);
    mx = fmaxf(mx, __shfl_xor(mx, 16, 64));
    mx = fmaxf(mx, __shfl_xor(mx, 32, 64));
    float sm = 0.f;
#pragma unroll
    for (int n = 0; n < 16; ++n)
#pragma unroll
      for (int j = 0; j < 4; ++j) { float ev = __expf((acc[n][j] - mx) * 0.125f); acc[n][j] = ev; sm += ev; }
    sm += __shfl_xor(sm, 16, 64);
    sm += __shfl_xor(sm, 32, 64);
    const float inv = 1.f / sm;
#pragma unroll
    for (int n = 0; n < 16; ++n)
      *(uint2*)(pw + fr * 264 + n * 16 + fq * 4) = pack4(acc[n][0] * inv, acc[n][1] * inv, acc[n][2] * inv, acc[n][3] * inv);
  }
  __syncthreads();
  f32x4 o[4];
#pragma unroll
  for (int n = 0; n < 4; ++n) o[n] = f32x4{0.f, 0.f, 0.f, 0.f};
  mma_strip_t<4, 8>(pw, 264, vmT, 256, o);
#pragma unroll
  for (int n = 0; n < 4; ++n) {
    uint2* gp = (uint2*)(P + (tok0 + fr) * PC + 1024 + h * 64 + n * 16 + fq * 4);
    float g[4];
    unpack4(*gp, g);
    if (!p.dry) *gp = pack4(o[n][0] * silu(g[0]), o[n][1] * silu(g[1]), o[n][2] * silu(g[2]), o[n][3] * silu(g[3]));
  }
}

__device__ __forceinline__ void ln_item(const Params& p, int l, int item) {
  const int lane = tidx() & 63, w = tidx() >> 6;
  const size_t row = (size_t)item * 4 + w;
  float4* x = (float4*)(p.out + row * 1024);
  float4 v[4];
  float s = 0.f;
#pragma unroll
  for (int i = 0; i < 4; ++i) { v[i] = x[lane + 64 * i]; s += v[i].x + v[i].y + v[i].z + v[i].w; }
  s = wave_sum(s);
  const float mean = s * (1.f / 1024.f);
  float s2 = 0.f;
#pragma unroll
  for (int i = 0; i < 4; ++i) {
    float a = v[i].x - mean, b = v[i].y - mean, c = v[i].z - mean, d = v[i].w - mean;
    s2 += a * a + b * b + c * c + d * d;
  }
  s2 = wave_sum(s2);
  const float rs = rsqrtf(s2 * (1.f / 1024.f) + 1e-5f);
  const float4* lw = (const float4*)(p.in[I_LNW] + l * 1024);
  const float4* lb = (const float4*)(p.in[I_LNB] + l * 1024);
#pragma unroll
  for (int i = 0; i < 4; ++i) {
    float4 wv = lw[lane + 64 * i], bv = lb[lane + 64 * i], o;
    o.x = (v[i].x - mean) * rs * wv.x + bv.x;
    o.y = (v[i].y - mean) * rs * wv.y + bv.y;
    o.z = (v[i].z - mean) * rs * wv.z + bv.z;
    o.w = (v[i].w - mean) * rs * wv.w + bv.w;
    if (!p.dry) {
      x[lane + 64 * i] = o;
      if (l + 1 < NL) {
        uint2 ov;
        ov.x = (unsigned)f2bf(o.x) | ((unsigned)f2bf(o.y) << 16);
        ov.y = (unsigned)f2bf(o.z) | ((unsigned)f2bf(o.w) << 16);
        ((uint2*)((u16*)(p.ws + OFF_PREP) + row * 1024))[lane + 64 * i] = ov;
      }
    }
  }
}

__device__ __forceinline__ unsigned touch_gla(const Params& p, int tn, bool out) {
  if (tn >= 2048) return 0u;
  const u16* P = (const u16*)(p.ws + OFF_P);
  const int tid = tidx(), s = tid & 63, wq = tid >> 6;
  const int b = tn >> 9, c = (tn >> 2) & 127, h = tn & 3;
  const size_t tok0 = (size_t)b * SEQ + c * 64;
  const int col = (wq == 0 ? C_GQ : wq == 1 ? C_GK : wq == 2 ? C_GV : C_GA) + (wq < 3 ? h * 64 : 0);
  unsigned r = *(const unsigned*)(P + (tok0 + s) * PC + col);
  if (out) {
    if (tid < 64) r ^= *(const unsigned*)((const u16*)(p.ws + OFF_GST) + ((size_t)((b * 128 + c) * 4 + h)) * 4096 + tid * 64);
    else if (tid >= 128 && tid < 192) r ^= *(const unsigned*)(P + (tok0 + tid - 128) * PC + h * 64);
  }
  return r;
}
__device__ __forceinline__ unsigned touch_ssd(const Params& p, int tn, bool out) {
  if (tn >= 2048) return 0u;
  const u16* P = (const u16*)(p.ws + OFF_P);
  const int tid = tidx(), s = tid & 63, wq = tid >> 6;
  const int b = tn >> 9, c = (tn >> 2) & 127, h = tn & 3, g = h >> 1;
  const size_t tok0 = (size_t)b * SEQ + c * 64;
  const int col = wq == 0 ? C_XBC + h * 64 : wq == 1 ? C_XBC + 256 + g * 64 : wq == 2 ? C_XBC + 384 + g * 64 : C_DT;
  unsigned r = *(const unsigned*)(P + (tok0 + s) * PC + col);
  if (out) {
    if (tid < 64) r ^= *(const unsigned*)((const u16*)(p.ws + OFF_SST) + ((size_t)((b * 128 + c) * 4 + h)) * 4096 + tid * 64);
    else if (tid >= 128 && tid < 192) r ^= *(const unsigned*)(P + (tok0 + tid - 128) * PC + 256 + h * 64);
  }
  return r;
}
__device__ __forceinline__ unsigned touch_s5(const Params& p, int tn) {
  if (tn >= 512) return 0u;
  const u16* P = (const u16*)(p.ws + OFF_P);
  const int tid = tidx();
  const size_t tok0 = (size_t)(tn >> 7) * SEQ + (tn & 127) * 64;
  return *(const unsigned*)(P + (tok0 + (tid >> 2)) * PC + C_S5U + (tid & 3) * 64);
}
__device__ __forceinline__ unsigned touch_prep(const Params& p, int tn) {
  if (tn >= 2048) return 0u;
  const u16* P = (const u16*)(p.ws + OFF_P);
  const int tid = tidx();
  const size_t tok0 = (size_t)tn * 16;
  if (tid < 238) return *(const unsigned*)(P + (tok0 - 1 + tid / 14) * PC + C_RW + (tid % 14) * 64);
  if (tid < 254) return *(const unsigned*)(P + (tok0 + tid - 238) * PC + C_VL);
  return 0u;
}
#define KEEP(x) asm volatile("" ::"v"(x))

#define FOR_ITEMS(N) for (int t = blockIdx.x; t < (N); t += gridDim.x)
#define RUNIT(bit, ...)                                                        \
  for (int rep_ = ((pq.probe >> (bit)) & 1) ? 0 : 1; rep_ < 2; ++rep_) {       \
    pq.dry = p.dry | (rep_ == 0);                                              \
    __VA_ARGS__                                                                \
  }
__device__ __forceinline__ void phaseB(const Params& p, int l, unsigned char* smem) {
  Params pq = p;
  RUNIT(8, FOR_ITEMS(2048) { unsigned pf = touch_prep(pq, t + gridDim.x); rwkv_prep_item(pq, l, t, smem); KEEP(pf); })
  RUNIT(9, FOR_ITEMS(2048) { unsigned pf = touch_gla(pq, t + gridDim.x, false); gla_item<false>(pq, l, t >> 9, (t >> 2) & 127, t & 3, smem); KEEP(pf); })
  RUNIT(10, FOR_ITEMS(2048) { unsigned pf = touch_ssd(pq, t + gridDim.x, false); ssd_item<false>(pq, l, t >> 9, (t >> 2) & 127, t & 3, smem); KEEP(pf); })
  RUNIT(11, FOR_ITEMS(512) s5_item<false>(pq, l, t >> 7, t & 127, smem);)
}
__device__ __forceinline__ void phaseC(const Params& p, int l, unsigned char* smem) {
  Params pq = p;
  RUNIT(12, __syncthreads(); FOR_ITEMS(16 * NSEG * 2 / 4) {
    const int wv_ = tidx() >> 6;
    if (wv_ & 1) rwkv_scan_wave<1, false>(pq, l, t * 4 + wv_, (float*)smem + wv_ * 3072);
    else rwkv_scan_wave<1, true>(pq, l, t * 4 + wv_, (float*)smem + wv_ * 3072);
  })
  RUNIT(13, FOR_ITEMS(256) {
              if (t < 128) state_scan_item(pq, (u16*)(p.ws + OFF_GST), (const float*)(p.ws + OFF_GDC), t);
              else state_scan_item(pq, (u16*)(p.ws + OFF_SST), (const float*)(p.ws + OFF_SDC), t - 128);
            }
            FOR_ITEMS(16) s5_scan_item(pq, l, t);)
  RUNIT(14, FOR_ITEMS(2048) memattn_item(pq, l, t >> 9, (t >> 7) & 3, t & 127, smem);)
}
__device__ __forceinline__ void phaseD(const Params& p, int l, unsigned char* smem) {
  Params pq = p;
  const bool split = (gridDim.x == 512);
#define FOR_REST(N) for (int t = split ? (int)blockIdx.x - 64 : (int)blockIdx.x; t >= 0 && t < (N); t += split ? 448 : (int)gridDim.x)
  RUNIT(13, FOR_ITEMS(64) rwkv_chain_item(pq, t, smem);)
  const int rst = split ? 448 : (int)gridDim.x;
  RUNIT(9, FOR_REST(4608) {
    const int tn = t + rst;
    unsigned pf = (tn < 2048) ? touch_gla(pq, tn, true) : (tn < 4096) ? touch_ssd(pq, tn - 2048, true) : touch_s5(pq, tn - 4096);
    if (t < 2048) gla_item<true>(pq, l, t >> 9, (t >> 2) & 127, t & 3, smem);
    else if (t < 4096) { const int u = t - 2048; ssd_item<true>(pq, l, u >> 9, (u >> 2) & 127, u & 3, smem); }
    else { const int u = t - 4096; s5_item<true>(pq, l, u >> 7, u & 127, smem); }
    KEEP(pf);
  })
#undef FOR_REST
}
__device__ __forceinline__ void phaseE(const Params& p, int l, unsigned char* smem) {
  Params pq = p;
  RUNIT(15, __syncthreads(); FOR_ITEMS(16 * NSEG / 4) {
    rwkv_scan_wave<3, true>(pq, l, t * 4 + (tidx() >> 6), (float*)smem + (tidx() >> 6) * 3072);
  })
  RUNIT(16, for (int t = (gridDim.x == 512) ? ((int)blockIdx.x >= 256 ? (int)blockIdx.x - 256 : 512) : (int)blockIdx.x; t < 512;
                 t += (gridDim.x == 512) ? 256 : (int)gridDim.x) {
    int mt = t >> 1, nt = t & 1;
    gemm_tile<EPI_GLU, false>(pq, l, (const u16*)(p.ws + OFF_P) + C_S5U, PC, (const u16*)(p.ws + OFF_GLU) + (size_t)l * 512 * 256, 256, mt * 128, nt * 256, smem);
  })
  if (l + 1 < NL) {
    const float* src = p.in[I_WINR] + (size_t)l * 1024 * 4020;
    for (int t = (gridDim.x == 512) ? ((int)blockIdx.x >= 256 ? (int)blockIdx.x - 256 : 1024) : (int)blockIdx.x; t < 1024;
         t += (gridDim.x == 512) ? 256 : (int)gridDim.x)
      tconv_tile(src, 4020, (u16*)(p.ws + OFF_WIN), 1024, (t / 16) * 64, (t % 16) * 64, 0, l + 1, (float*)smem, p.dry);
  }
}
__device__ __forceinline__ void phaseF(const Params& p, int l, unsigned char* smem) {
  FOR_ITEMS(256 * 4) {
    int mt = t >> 2, nt = t & 3;
    if (gridDim.x == 512) {
      const int r = t >> 9, x = blockIdx.x & 7, k = blockIdx.x >> 3;
      mt = x * 32 + r * 16 + (k >> 2);
      nt = k & 3;
    }
    gemm_tile<EPI_OUT, false>(p, l, (const u16*)(p.ws + OFF_P), PC, (const u16*)(p.ws + OFF_WOUT) + (size_t)l * 1024 * 1280, 1280, mt * 128, nt * 256, smem);
  }
}
__device__ __forceinline__ void phaseG(const Params& p, int l, unsigned char* smem) {
  FOR_ITEMS(NTOK / 4) ln_item(p, l, t);
}


#define XB_TMO      128
#define XB_XCNT(j)  (256  + 64 * (j))
#define XB_XSUB(j)  (1280 + 64 * (j))
#define XB_XGEN(j)  (2304 + 64 * (j))
#define XB_TOP      3328
#define XB_TOPGEN   3392
#define XCD_BAR_WORDS 3456
#define XB_SPIN_CAP (1u << 22)
#define LAS __attribute__((address_space(3)))
__device__ __forceinline__ unsigned xb_ld(unsigned* p)              { return __hip_atomic_load(p, __ATOMIC_RELAXED, __HIP_MEMORY_SCOPE_AGENT); }
__device__ __forceinline__ unsigned xb_add(unsigned* p, unsigned v) { return __hip_atomic_fetch_add(p, v, __ATOMIC_RELAXED, __HIP_MEMORY_SCOPE_AGENT); }
__device__ __forceinline__ unsigned xb_xcc_id() { return (unsigned)__builtin_amdgcn_s_getreg((3 << 11) | 20) & 0xFu; }
#define XB_SPIN(cond, bar) do { unsigned _sp = 0; while (cond) { __builtin_amdgcn_s_sleep(1); \
    if ((++_sp & 255u) == 0u) { if (xb_ld(&(bar)[XB_TMO])) break; if (_sp > XB_SPIN_CAP) { atomicAdd(&(bar)[XB_TMO], 1u); break; } } } } while (0)
struct XcdBarrier { unsigned* bar; unsigned x; volatile LAS unsigned* st; };
__device__ __forceinline__ XcdBarrier xcd_barrier_post(unsigned* bar, volatile LAS unsigned* st) {
  XcdBarrier b; b.bar = bar; b.x = xb_xcc_id(); b.st = st;
  if (threadIdx.x == 0) (void)xb_add(&bar[XB_XCNT(b.x)], 1u);
  return b;
}
__device__ __forceinline__ void xcd_barrier_complete(unsigned* bar, unsigned x, unsigned& nloc, unsigned& nx) {
  const unsigned G = gridDim.x * gridDim.y * gridDim.z;
  unsigned sum, cnt, mine, sp = 0u;
  for (;;) {
    sum = 0u; cnt = 0u; mine = 0u;
#pragma unroll
    for (unsigned j = 0; j < 16; ++j) { const unsigned c = xb_ld(&bar[XB_XCNT(j)]); sum += c; cnt += (c > 0u) ? 1u : 0u; mine = (j == x) ? c : mine; }
    if (sum == G) break;
    __builtin_amdgcn_s_sleep(1);
    if ((++sp & 255u) == 0u) { if (xb_ld(&bar[XB_TMO])) break; if (sp > XB_SPIN_CAP) { atomicAdd(&bar[XB_TMO], 1u); break; } }
  }
  nloc = mine > 0u ? mine : 1u; nx = cnt > 0u ? cnt : 1u;
}
__device__ __forceinline__ void xcd_barrier(const XcdBarrier& b) {
  asm volatile("s_waitcnt vmcnt(0)" ::: "memory");
  __syncthreads();
  if (threadIdx.x == 0) {
    unsigned* bar = b.bar;
    __builtin_amdgcn_s_waitcnt(0);
    unsigned nloc = b.st[0], nx = b.st[1];
    if (nloc == 0u) { xcd_barrier_complete(bar, b.x, nloc, nx); b.st[0] = nloc; b.st[1] = nx; }
    const unsigned old = xb_add(&bar[XB_XSUB(b.x)], 1u);
    const unsigned gen = old / nloc;
    if (old + 1u == (gen + 1u) * nloc) {
      __builtin_amdgcn_fence(__ATOMIC_RELEASE, "agent");
      asm volatile("s_waitcnt vmcnt(0)" ::: "memory");
      const unsigned og = xb_add(&bar[XB_TOP], 1u);
      const unsigned tg = og / nx;
      if (og + 1u == (tg + 1u) * nx) xb_add(&bar[XB_TOPGEN], 1u);
      else XB_SPIN(xb_ld(&bar[XB_TOPGEN]) == tg, bar);
      __builtin_amdgcn_fence(__ATOMIC_ACQUIRE, "agent");
      xb_add(&bar[XB_XGEN(b.x)], 1u);
      asm volatile("s_waitcnt vmcnt(0)" ::: "memory");
    } else {
      XB_SPIN(xb_ld(&bar[XB_XGEN(b.x)]) == gen, bar);
      __builtin_amdgcn_fence(__ATOMIC_ACQUIRE, "agent");
      asm volatile("s_waitcnt vmcnt(0)" ::: "memory");
    }
  }
  __syncthreads();
}

#if MK_ONE
__global__ void __launch_bounds__(256, 2) mega_kernel(Params p) {
  __shared__ __attribute__((aligned(16))) unsigned char smem[SMEM_BYTES];
  cg::grid_group grid = cg::this_grid();
#ifndef PROBE_SYNC
#define PROBE_SYNC 0
#endif
#define GSYNC for (int sy_ = 0; sy_ <= PROBE_SYNC; ++sy_) xcd_barrier(xb)
  __shared__ uint4 xb_words;
  if (threadIdx.x == 0) xb_words = make_uint4(0u, 0u, 0u, 0u);
  __syncthreads();
  XcdBarrier xb = xcd_barrier_post((unsigned*)(p.ws + OFF_BAR), (volatile LAS unsigned*)&xb_words);
#ifndef TESTM
#define TESTM 255
#endif
#define RUNPH(bit, call)                                              \
  for (int rep = ((pp.probe >> (bit)) & 1) ? 0 : 1; rep < 2; ++rep) {  \
    pp.dry = (rep == 0);                                              \
    call;                                                             \
  }
  Params pp = p;
  RUNPH(0, phase0(pp, smem));
  GSYNC;
#pragma unroll 1
  for (int l = 0; l < NL; ++l) {
    RUNPH(1, phaseA(pp, l, smem)); GSYNC;
    RUNPH(2, phaseB(pp, l, smem)); GSYNC;
    RUNPH(3, phaseC(pp, l, smem)); GSYNC;
    RUNPH(4, phaseD(pp, l, smem)); GSYNC;
    RUNPH(5, phaseE(pp, l, smem)); GSYNC;
    RUNPH(6, phaseF(pp, l, smem));
    if (l + 1 < NL) GSYNC;
  }
  if (p.probe == 0x7fffffff) grid.sync();
}
#else
template <int PH>
__global__ void __launch_bounds__(256, 2) phase_kernel(Params p, int l) {
  __shared__ __attribute__((aligned(16))) unsigned char smem[SMEM_BYTES];
  if (PH == 0) phase0(p, smem);
  if (PH == 1) phaseA(p, l, smem);
  if (PH == 2) phaseB(p, l, smem);
  if (PH == 3) phaseC(p, l, smem);
  if (PH == 4) phaseD(p, l, smem);
  if (PH == 5) phaseE(p, l, smem);
  if (PH == 6) phaseF(p, l, smem);
  if (PH == 7) phaseG(p, l, smem);
}
#endif

extern "C" void kernel_launch(void* const* d_in, const int* in_sizes, int n_in, void* d_out, int out_size, void* d_ws,
                              size_t ws_size, hipStream_t stream) {
  Params p{};
  for (int i = 0; i < N_IN; ++i) p.in[i] = (const float*)d_in[i];
  p.out = (float*)d_out;
  p.ws = (unsigned char*)d_ws;
#ifndef PROBE_MASK
#define PROBE_MASK 0
#endif
  p.probe = PROBE_MASK;
  p.dry = 0;
  if (ws_size < WS_TOTAL) fprintf(stderr, "workspace too small: %zu < %zu\n", ws_size, (size_t)WS_TOTAL);
#if MK_ONE
  static int grid_blocks = 0;
  if (!grid_blocks) {
    int dev = 0, cus = 0, per_cu = 0;
    hipGetDevice(&dev);
    hipDeviceGetAttribute(&cus, hipDeviceAttributeMultiprocessorCount, dev);
    hipOccupancyMaxActiveBlocksPerMultiprocessor(&per_cu, mega_kernel, 256, 0);
    if (per_cu < 1) per_cu = 1;
    if (per_cu > 2) per_cu = 2;
    grid_blocks = cus * per_cu;
  }
  hipMemsetAsync((unsigned char*)d_ws + OFF_BAR, 0, 16384, stream);
  void* args[] = {&p};
  hipError_t e = hipLaunchCooperativeKernel((void*)mega_kernel, dim3(grid_blocks), dim3(256), args, 0, stream);
  if (e != hipSuccess) fprintf(stderr, "cooperative launch failed: %s (grid %d)\n", hipGetErrorString(e), grid_blocks);
#else
  const int G = 1024;
  phase_kernel<0><<<G, 256, 0, stream>>>(p, 0);
  for (int l = 0; l < NL; ++l) {
    phase_kernel<1><<<G, 256, 0, stream>>>(p, l);
    phase_kernel<2><<<G, 256, 0, stream>>>(p, l);
    phase_kernel<3><<<G, 256, 0, stream>>>(p, l);
    phase_kernel<4><<<G, 256, 0, stream>>>(p, l);
    phase_kernel<5><<<G, 256, 0, stream>>>(p, l);
    phase_kernel<6><<<G, 256, 0, stream>>>(p, l);
    phase_kernel<7><<<G, 256, 0, stream>>>(p, l);
  }
#endif
}
```

```cpp
#include <hip/hip_runtime.h>
#include <hip/hip_cooperative_groups.h>
#include <cstdio>
namespace cg = cooperative_groups;

#ifndef MK_ONE
#define MK_ONE 1
#endif

typedef unsigned short u16;
using bf16x8 = __attribute__((ext_vector_type(8))) short;
using f32x4 = __attribute__((ext_vector_type(4))) float;

constexpr int NTOK = 32768, SEQ = 8192, NL = 4;
constexpr int PC = 4032;
constexpr int C_GQ = 1280, C_GK = 1536, C_GV = 1792, C_XBC = 2048, C_S5U = 2560, C_RW = 2816, C_MQ = 3712,
              C_GA = 3968, C_DT = 3984, C_VL = 4000;
constexpr int NSEG = 64, SEGLEN = 128;
constexpr float ALPHA = 1.6817928305074290f;

enum { I_X, I_MEM, I_WIN0, I_WINR, I_GLA_WA2, I_GLA_BA, I_GLA_NW, I_SSD_CW, I_SSD_CB, I_SSD_DTB, I_SSD_ALOG, I_SSD_D,
       I_SSD_NW, I_S5_ARE, I_S5_AIM, I_S5_BRE, I_S5_BIM, I_S5_CRE, I_S5_CIM, I_S5_LOGDT, I_S5_D, I_S5_GLUW, I_S5_GLUB,
       I_RW_MU, I_RW_W0, I_RW_W2, I_RW_A0, I_RW_A2, I_RW_V0, I_RW_V2, I_RW_KK, I_RW_KA, I_RW_RK, I_RW_GNW, I_RW_GNB,
       I_MEM_WKV, I_WOUT, I_LNW, I_LNB, N_IN };

struct Params {
  const float* in[N_IN];
  float* out;
  unsigned char* ws;
  int probe;
  int dry;
};

constexpr size_t SZ_P = (size_t)NTOK * PC * 2;
constexpr size_t OFF_P = 0;
constexpr size_t OFF_WIN = OFF_P + SZ_P;
constexpr size_t OFF_WOUT = OFF_WIN + (size_t)1 * 4096 * 1024 * 2;
constexpr size_t OFF_GLU = OFF_WOUT + (size_t)4 * 1024 * 1280 * 2;
constexpr size_t OFF_MKV = OFF_GLU + (size_t)4 * 512 * 256 * 2;
constexpr size_t OFF_S5A = OFF_MKV + (size_t)4 * 512 * 1024 * 2;
constexpr size_t OFF_S5A64 = OFF_S5A + 4 * 16 * 64 * 2 * 4;
constexpr size_t OFF_S5B = OFF_S5A64 + 4 * 16 * 64 * 2 * 4;
constexpr size_t OFF_S5C = OFF_S5B + (size_t)4 * 16 * 128 * 32 * 2;
constexpr size_t OFF_KM = OFF_S5C + (size_t)4 * 16 * 16 * 128 * 2;
constexpr size_t OFF_VMT = OFF_KM + (size_t)4 * 1024 * 256 * 2;
constexpr size_t OFF_PREP = OFF_VMT + (size_t)4 * 4 * 256 * 256 * 2;
constexpr size_t SZ_PREP1 = (size_t)NTOK * 256 * 2;
constexpr size_t OFF_VF = OFF_PREP + 6 * SZ_PREP1;
constexpr size_t OFF_GST = OFF_VF + SZ_PREP1;
constexpr size_t SZ_ST = (size_t)4 * 128 * 4 * 4096 * 4;
constexpr size_t OFF_GDC = OFF_GST + SZ_ST;
constexpr size_t SZ_DC = (size_t)4 * 128 * 4 * 64 * 4;
constexpr size_t OFF_SST = OFF_GDC + SZ_DC;
constexpr size_t OFF_SDC = OFF_SST + SZ_ST;
constexpr size_t OFF_S5X = OFF_SDC + SZ_DC;
constexpr size_t OFF_RSL = OFF_S5X + (size_t)4 * 128 * 16 * 64 * 2 * 4;
constexpr size_t SZ_RS = (size_t)16 * NSEG * 4096 * 4;
constexpr size_t OFF_RPM = OFF_RSL + SZ_RS;
constexpr size_t OFF_BAR = OFF_RPM + SZ_RS;
constexpr size_t OFF_MEMB = OFF_BAR + 16384;
constexpr size_t OFF_LNX = OFF_MEMB + (size_t)1024 * 1024 * 2;
constexpr size_t OFF_W2T = OFF_LNX + (size_t)256 * 4 * 128 * 8;
constexpr size_t OFF_A2T = OFF_W2T + (size_t)4 * 256 * 64 * 2;
constexpr size_t OFF_V2T = OFF_A2T + (size_t)4 * 256 * 64 * 2;
constexpr size_t OFF_W2L = OFF_V2T + (size_t)3 * 256 * 32 * 2;
constexpr size_t WS_TOTAL = OFF_W2L + (size_t)4 * 256 * 64 * 2;

constexpr int SMEM_BYTES = 49152;

__device__ __forceinline__ int tidx() { int t = threadIdx.x; asm volatile("" : "+v"(t)); return t; }
__device__ __forceinline__ u16 f2bf(float f) {
  unsigned u = __float_as_uint(f);
  u += 0x7fffu + ((u >> 16) & 1u);
  return (u16)(u >> 16);
}
__device__ __forceinline__ float bf2f(u16 h) { return __uint_as_float(((unsigned)h) << 16); }
__device__ __forceinline__ float sigm(float x) { return 1.f / (1.f + __expf(-x)); }
__device__ __forceinline__ float silu(float x) { return x / (1.f + __expf(-x)); }
__device__ __forceinline__ float softplus(float x) { return fmaxf(x, 0.f) + log1pf(__expf(-fabsf(x))); }
__device__ __forceinline__ float gelu_tanh(float x) {
  float u = 0.7978845608028654f * (x + 0.044715f * x * x * x);
  return 0.5f * x * (1.f + tanhf(u));
}
#define DPP_ADD(v, CTRL) ((v) + __int_as_float(__builtin_amdgcn_update_dpp(0, __float_as_int(v), (CTRL), 0xf, 0xf, false)))
__device__ __forceinline__ float wave_sum(float v) {
  v = DPP_ADD(v, 0xB1);
  v = DPP_ADD(v, 0x4E);
  v = DPP_ADD(v, 0x141);
  v = DPP_ADD(v, 0x140);
  const int iv = __float_as_int(v);
  return __int_as_float(__builtin_amdgcn_readlane(iv, 0)) + __int_as_float(__builtin_amdgcn_readlane(iv, 16)) +
         __int_as_float(__builtin_amdgcn_readlane(iv, 32)) + __int_as_float(__builtin_amdgcn_readlane(iv, 48));
}
__device__ __forceinline__ float sum16(float v) {
#pragma unroll
  for (int m = 8; m >= 1; m >>= 1) v += __shfl_xor(v, m, 64);
  return v;
}
__device__ __forceinline__ float max16(float v) {
#pragma unroll
  for (int m = 8; m >= 1; m >>= 1) v = fmaxf(v, __shfl_xor(v, m, 64));
  return v;
}

template <int NT, int KS>
__device__ __forceinline__ void mma_strip(const u16* A, int lda, const u16* Bt, int ldb, f32x4 (&acc)[NT]) {
  const int lane = tidx() & 63, fr = lane & 15, fq = lane >> 4;
#pragma unroll
  for (int ks = 0; ks < KS; ++ks) {
    bf16x8 a = *(const bf16x8*)(A + fr * lda + ks * 32 + fq * 8);
#pragma unroll
    for (int n = 0; n < NT; ++n) {
      bf16x8 b = *(const bf16x8*)(Bt + (n * 16 + fr) * ldb + ks * 32 + fq * 8);
      acc[n] = __builtin_amdgcn_mfma_f32_16x16x32_bf16(a, b, acc[n], 0, 0, 0);
    }
  }
}

template <int NT, int KS>
__device__ __forceinline__ void mma_strip_t(const u16* A, int lda, const u16* Bt, int ldb, f32x4 (&acc)[NT]) {
  const int lane = tidx() & 63, fr = lane & 15, fq = lane >> 4;
#pragma unroll
  for (int ks = 0; ks < KS; ++ks) {
    bf16x8 a = *(const bf16x8*)(A + fr * lda + ks * 32 + fq * 8);
#pragma unroll
    for (int n = 0; n < NT; ++n) {
      bf16x8 b = *(const bf16x8*)(Bt + (n * 16 + fr) * ldb + ks * 32 + fq * 8);
      acc[n] = __builtin_amdgcn_mfma_f32_16x16x32_bf16(b, a, acc[n], 0, 0, 0);
    }
  }
}
__device__ __forceinline__ uint2 pack4(float a, float b, float c, float d) {
  uint2 o;
  o.x = (unsigned)f2bf(a) | ((unsigned)f2bf(b) << 16);
  o.y = (unsigned)f2bf(c) | ((unsigned)f2bf(d) << 16);
  return o;
}
__device__ __forceinline__ void unpack4(const uint2& u, float* o) {
  o[0] = __uint_as_float(u.x << 16); o[1] = __uint_as_float(u.x & 0xffff0000u);
  o[2] = __uint_as_float(u.y << 16); o[3] = __uint_as_float(u.y & 0xffff0000u);
}

enum { EPI_P, EPI_MEMKV, EPI_OUT, EPI_GLU };

template <int EPI, bool AF32>
__device__ __forceinline__ void gemm_tile(const Params& p, int layer, const void* Av, int lda, const u16* Bt, int K, int m0, int n0,
                          unsigned char* smem) {
  u16* sA = (u16*)smem;
  u16* sB = sA + 2 * 128 * 32;
  const int tid = tidx(), lane = tid & 63, w = tid >> 6, wr = w >> 1, wc = w & 1, fr = lane & 15, fq = lane >> 4;
  f32x4 acc[4][8];
#pragma unroll
  for (int m = 0; m < 4; ++m)
#pragma unroll
    for (int n = 0; n < 8; ++n) acc[m][n] = f32x4{0.f, 0.f, 0.f, 0.f};
  uint4 qa0_0, qa0_1, qb0_0, qb0_1, qb0_2, qb0_3;
  uint4 qa1_0, qa1_1, qb1_0, qb1_1, qb1_2, qb1_3;
  const int nk = K / 32;
  const u16* Ag = (const u16*)Av;
  const int lrow = tid >> 2, lc8 = (tid & 3) * 8;
  const u16* gA = Ag + (size_t)(m0 + lrow) * lda + lc8;
  const u16* gB = Bt + (size_t)(n0 + lrow) * K + lc8;
  const size_t a64 = (size_t)64 * lda, b64 = (size_t)64 * K;
  const int sw = lrow * 32 + (((tid & 3) ^ ((lrow >> 2) & 3)) * 8);
  const int rsw = (fq ^ ((fr >> 2) & 3)) * 8;
  __syncthreads();
#define GLOAD(S, kt)                                   \
  {                                                    \
    const int k0 = (kt) * 32;                          \
    qa##S##_0 = *(const uint4*)(gA + k0);              \
    qa##S##_1 = *(const uint4*)(gA + a64 + k0);        \
    qb##S##_0 = *(const uint4*)(gB + k0);              \
    qb##S##_1 = *(const uint4*)(gB + b64 + k0);        \
    qb##S##_2 = *(const uint4*)(gB + 2 * b64 + k0);    \
    qb##S##_3 = *(const uint4*)(gB + 3 * b64 + k0);    \
  }
#define SSTORE(S, buf)                                 \
  {                                                    \
    u16* a_ = sA + (buf) * 128 * 32;                   \
    u16* b_ = sB + (buf) * 256 * 32;                   \
    *(uint4*)(a_ + sw) = qa##S##_0;                    \
    *(uint4*)(a_ + 64 * 32 + sw) = qa##S##_1;          \
    *(uint4*)(b_ + sw) = qb##S##_0;                    \
    *(uint4*)(b_ + 64 * 32 + sw) = qb##S##_1;          \
    *(uint4*)(b_ + 128 * 32 + sw) = qb##S##_2;         \
    *(uint4*)(b_ + 192 * 32 + sw) = qb##S##_3;         \
  }
#define GSTEP(U, S)                                                                                 \
  {                                                                                                 \
    const int kt = kt0 + (U);                                                                       \
    if (kt < nk) {                                                                                  \
      {                                                                                             \
        const u16* a_ = sA + (kt & 1) * 128 * 32 + (wr * 64) * 32;                                  \
        const u16* b_ = sB + (kt & 1) * 256 * 32 + (wc * 128) * 32;                                 \
        bf16x8 af[4];                                                                               \
        _Pragma("unroll") for (int m = 0; m < 4; ++m) af[m] = *(const bf16x8*)(a_ + (m * 16 + fr) * 32 + rsw);      \
        __builtin_amdgcn_s_setprio(1);                                                              \
        _Pragma("unroll") for (int nh = 0; nh < 2; ++nh) {                                          \
          bf16x8 bfr[4];                                                                            \
          _Pragma("unroll") for (int n = 0; n < 4; ++n) bfr[n] = *(const bf16x8*)(b_ + ((nh * 4 + n) * 16 + fr) * 32 + rsw); \
          _Pragma("unroll") for (int m = 0; m < 4; ++m)                                             \
            _Pragma("unroll") for (int n = 0; n < 4; ++n)                                           \
              acc[m][nh * 4 + n] = __builtin_amdgcn_mfma_f32_16x16x32_bf16(bfr[n], af[m], acc[m][nh * 4 + n], 0, 0, 0); \
        }                                                                                           \
        __builtin_amdgcn_s_setprio(0);                                                              \
      }                                                                                             \
      if (kt + 1 < nk) SSTORE(S, (kt + 1) & 1);                                                     \
      if (kt + 2 < nk) GLOAD(0, kt + 2);                                                            \
      __syncthreads();                                                                              \
    }                                                                                               \
  }
  GLOAD(0, 0);
  qa1_0 = qa1_1 = qb1_0 = qb1_1 = qb1_2 = qb1_3 = make_uint4(0, 0, 0, 0);
  if (nk > 1) GLOAD(1, 1);
  SSTORE(0, 0);
  __syncthreads();
  {
    const int kt0 = 0;
    GSTEP(0, 1);
  }
#pragma unroll 1
  for (int kt0 = 1; kt0 < nk; ++kt0) {
    GSTEP(0, 0);
  }
#undef GLOAD
#undef SSTORE
#undef GSTEP
  u16* P = (u16*)(p.ws + OFF_P);
  if (EPI == EPI_GLU) {
    const float* gb = p.in[I_S5_GLUB] + layer * 512;
#pragma unroll
    for (int m = 0; m < 4; ++m)
#pragma unroll
      for (int n2 = 0; n2 < 4; ++n2) {
        if ((n2 & 1) == 0) __builtin_amdgcn_sched_barrier(0);
        const int cb = n0 + wc * 128 + n2 * 32;
        const int c0 = (cb >> 5) * 16 + fq * 4;
        const int row = m0 + wr * 64 + m * 16 + fr;
        const size_t a = (size_t)row * PC + 512 + c0;
        const uint2 gq = *(const uint2*)(P + a);
        const float g[4] = {__uint_as_float(gq.x << 16), __uint_as_float(gq.x & 0xffff0000u),
                            __uint_as_float(gq.y << 16), __uint_as_float(gq.y & 0xffff0000u)};
        float o[4];
#pragma unroll
        for (int j = 0; j < 4; ++j) {
          float val = acc[m][n2 * 2][j] + gb[c0 + j];
          float gt = acc[m][n2 * 2 + 1][j] + gb[256 + c0 + j];
          o[j] = val * sigm(gt) * silu(g[j]);
        }
        uint2 ov;
        ov.x = (unsigned)f2bf(o[0]) | ((unsigned)f2bf(o[1]) << 16);
        ov.y = (unsigned)f2bf(o[2]) | ((unsigned)f2bf(o[3]) << 16);
        if (!p.dry) *(uint2*)(P + a) = ov;
      }
    return;
  }
  if (EPI == EPI_P) {
    u16* cw = (u16*)smem + w * (64 * 72);
#pragma unroll
    for (int nh = 0; nh < 2; ++nh) {
      if (nh) __syncthreads();
#pragma unroll
      for (int m = 0; m < 4; ++m)
#pragma unroll
        for (int n = 0; n < 4; ++n) {
          const f32x4 v = acc[m][nh * 4 + n];
          uint2 ov;
          ov.x = (unsigned)f2bf(v[0]) | ((unsigned)f2bf(v[1]) << 16);
          ov.y = (unsigned)f2bf(v[2]) | ((unsigned)f2bf(v[3]) << 16);
          *(uint2*)(cw + (m * 16 + fr) * 72 + n * 16 + fq * 4) = ov;
        }
      __syncthreads();
      const int colb = n0 + wc * 128 + nh * 64;
      if (colb < PC && !p.dry) {
#pragma unroll
        for (int i = 0; i < 8; ++i) {
          const int r = i * 8 + (lane >> 3), c8 = (lane & 7) * 8;
          const uint4 v = *(const uint4*)(cw + r * 72 + c8);
          *(uint4*)(P + (size_t)(m0 + wr * 64 + r) * PC + colb + c8) = v;
        }
      }
    }
    return;
  }
  if (EPI == EPI_OUT) {
    if (p.dry) return;
    const float* xr = (layer == 0) ? p.in[I_X] : p.out;
    float s1[4], s2[4];
#pragma unroll
    for (int m = 0; m < 4; ++m) {
      const int row = m0 + wr * 64 + m * 16 + fr;
      float a1 = 0.f, a2 = 0.f;
#pragma unroll
      for (int n = 0; n < 8; ++n) {
        const int col = n0 + wc * 128 + n * 16 + fq * 4;
        const float4 xv = *(const float4*)(xr + (size_t)row * 1024 + col);
        f32x4 z = acc[m][n];
        z[0] += ALPHA * xv.x; z[1] += ALPHA * xv.y; z[2] += ALPHA * xv.z; z[3] += ALPHA * xv.w;
        acc[m][n] = z;
        a1 += z[0] + z[1] + z[2] + z[3];
        a2 += z[0] * z[0] + z[1] * z[1] + z[2] * z[2] + z[3] * z[3];
      }
      a1 += __shfl_xor(a1, 16, 64); a1 += __shfl_xor(a1, 32, 64);
      a2 += __shfl_xor(a2, 16, 64); a2 += __shfl_xor(a2, 32, 64);
      s1[m] = a1; s2[m] = a2;
    }
    float* red = (float*)smem;
    if (fq == 0) {
#pragma unroll
      for (int m = 0; m < 4; ++m) {
        const int rl = wr * 64 + m * 16 + fr;
        red[(rl * 2 + wc) * 2] = s1[m];
        red[(rl * 2 + wc) * 2 + 1] = s2[m];
      }
    }
    __syncthreads();
    const int mt = m0 >> 7, nt = n0 >> 8;
    unsigned long long* lnx = (unsigned long long*)(p.ws + OFF_LNX);
    unsigned* cnt = (unsigned*)(p.ws + OFF_BAR) + 3584 + mt;
    if (tid < 128) {
      const float t1 = red[(tid * 2) * 2] + red[(tid * 2 + 1) * 2];
      const float t2 = red[(tid * 2) * 2 + 1] + red[(tid * 2 + 1) * 2 + 1];
      const unsigned long long pk = ((unsigned long long)__float_as_uint(t2) << 32) | (unsigned long long)__float_as_uint(t1);
      __hip_atomic_store(lnx + ((size_t)mt * 4 + nt) * 128 + tid, pk, __ATOMIC_RELAXED, __HIP_MEMORY_SCOPE_AGENT);
    }
    asm volatile("s_waitcnt vmcnt(0)" ::: "memory");
    __syncthreads();
    if (tid == 0) {
      __hip_atomic_fetch_add(cnt, 1u, __ATOMIC_RELEASE, __HIP_MEMORY_SCOPE_AGENT);
      const unsigned target = 4u * (unsigned)(layer + 1);
      unsigned spins = 0;
      while (__hip_atomic_load(cnt, __ATOMIC_RELAXED, __HIP_MEMORY_SCOPE_AGENT) < target) {
        __builtin_amdgcn_s_sleep(1);
        if (++spins > (1u << 24)) break;
      }
      __builtin_amdgcn_fence(__ATOMIC_ACQUIRE, "agent");
    }
    __syncthreads();
    const float* lw = p.in[I_LNW] + layer * 1024;
    const float* lb = p.in[I_LNB] + layer * 1024;
    u16* Xb = (u16*)(p.ws + OFF_PREP);
#pragma unroll
    for (int m = 0; m < 4; ++m) {
      const int rl = wr * 64 + m * 16 + fr;
      const int row = m0 + rl;
      float t1 = 0.f, t2 = 0.f;
#pragma unroll
      for (int q = 0; q < 4; ++q) {
        const unsigned long long pk = __hip_atomic_load(lnx + ((size_t)mt * 4 + q) * 128 + rl, __ATOMIC_RELAXED, __HIP_MEMORY_SCOPE_AGENT);
        t1 += __uint_as_float((unsigned)(pk & 0xffffffffull));
        t2 += __uint_as_float((unsigned)(pk >> 32));
      }
      const float mean = t1 * (1.f / 1024.f);
      const float var = fmaxf(t2 * (1.f / 1024.f) - mean * mean, 0.f);
      const float rs = rsqrtf(var + 1e-5f);
#pragma unroll
      for (int n = 0; n < 8; ++n) {
        const int col = n0 + wc * 128 + n * 16 + fq * 4;
        const float4 wv = *(const float4*)(lw + col);
        const float4 bv = *(const float4*)(lb + col);
        const f32x4 z = acc[m][n];
        float4 o;
        o.x = (z[0] - mean) * rs * wv.x + bv.x;
        o.y = (z[1] - mean) * rs * wv.y + bv.y;
        o.z = (z[2] - mean) * rs * wv.z + bv.z;
        o.w = (z[3] - mean) * rs * wv.w + bv.w;
        *(float4*)(p.out + (size_t)row * 1024 + col) = o;
        if (layer + 1 < NL) *(uint2*)(Xb + (size_t)row * 1024 + col) = pack4(o.x, o.y, o.z, o.w);
      }
    }
    return;
  }
#pragma unroll
  for (int m = 0; m < 4; ++m)
#pragma unroll
    for (int n = 0; n < 8; ++n) {
      if ((n & 3) == 0) __builtin_amdgcn_sched_barrier(0);
      const int row = m0 + wr * 64 + m * 16 + fr;
      const int col = n0 + wc * 128 + n * 16 + fq * 4;
      const f32x4 v = acc[m][n];
      if (EPI == EPI_MEMKV) {
        u16* km = (u16*)(p.ws + OFF_KM) + (size_t)layer * 1024 * 256;
        u16* vmT = (u16*)(p.ws + OFF_VMT) + (size_t)layer * 4 * 256 * 256;
        if (!p.dry) {
#pragma unroll
          for (int j = 0; j < 4; ++j) {
            int cj = col + j;
            if (cj < 256) km[(size_t)row * 256 + cj] = f2bf(v[j]);
            else {
              int b = row >> 8, mm = row & 255;
              vmT[((size_t)b * 256 + (cj - 256)) * 256 + mm] = f2bf(v[j]);
            }
          }
        }
      } else if (EPI == EPI_OUT) {
        const float* xr = (layer == 0) ? p.in[I_X] : p.out;
        const size_t a = (size_t)row * 1024 + col;
        const float4 xv = *(const float4*)(xr + a);
        float4 o;
        o.x = ALPHA * xv.x + v[0]; o.y = ALPHA * xv.y + v[1]; o.z = ALPHA * xv.z + v[2]; o.w = ALPHA * xv.w + v[3];
        if (!p.dry) *(float4*)(p.out + a) = o;
      }
    }
}

__device__ __forceinline__ int win_src_col(int n, int layer) {
  if (n < 2048) return n;
  if (n < 2560) return n - 2048 + 2064;
  if (n < 2816) return n - 2560 + 2580;
  if (n < 3712) return n - 2816 + 2836;
  if (n < 3968) return n - 3712 + 3732;
  if (n < 3984) return n - 3968 + 2048;
  if (n < 3988) return n - 3984 + 2576;
  if (n < 4000) return -1;
  if (n < 4032) return layer == 0 ? -1 : (n - 4000 + 3988);
  return -1;
}
__device__ __forceinline__ void tconv_tile(const float* src, int src_ld, u16* dst, int K, int n0, int k0, int kind, int layer, float* tile, int dry = 0) {
  const int tid = tidx();
  __syncthreads();
  {
    int nn = tid & 63, n = n0 + nn;
    int sc;
    if (kind == 0) sc = win_src_col(n, layer);
    else if (kind == 1) sc = n;
    else sc = ((n >> 5) * 16 + (n & 15)) + 256 * ((n >> 4) & 1);
#pragma unroll
    for (int i = 0; i < 16; ++i) {
      int kk = (tid >> 6) + 4 * i;
      float v = (sc >= 0) ? src[(size_t)(k0 + kk) * src_ld + sc] : 0.f;
      tile[kk * 65 + nn] = v;
    }
  }
  __syncthreads();
  {
    int kk = tid & 63;
#pragma unroll
    for (int i = 0; i < 16; ++i) {
      int nn = (tid >> 6) + 4 * i;
      if (!dry) dst[(size_t)(n0 + nn) * K + k0 + kk] = f2bf(tile[kk * 65 + nn]);
    }
  }
}

__device__ __forceinline__ void s5_params_item(const Params& p, int l, int g) {
  const int tid = tidx();
  float* Abar = (float*)(p.ws + OFF_S5A) + ((size_t)(l * 16 + g) * 64) * 2;
  float* A64 = (float*)(p.ws + OFF_S5A64) + ((size_t)(l * 16 + g) * 64) * 2;
  u16* Bb = (u16*)(p.ws + OFF_S5B) + (size_t)(l * 16 + g) * 128 * 32;
  u16* Cm = (u16*)(p.ws + OFF_S5C) + (size_t)(l * 16 + g) * 16 * 128;
  const int pp = tid & 63, sub = tid >> 6;
  float are = p.in[I_S5_ARE][(l * 16 + g) * 64 + pp], aim = p.in[I_S5_AIM][(l * 16 + g) * 64 + pp];
  float dt = expf(p.in[I_S5_LOGDT][l * 16 + g]);
  float mag = expf(are * dt);
  float sn, cs;
  sincosf(aim * dt, &sn, &cs);
  float abr = mag * cs, abi = mag * sn;
  float nr = abr - 1.f, ni = abi;
  float den = are * are + aim * aim;
  float fr_ = (nr * are + ni * aim) / den, fi_ = (ni * are - nr * aim) / den;
  if (sub == 0) {
    Abar[pp * 2] = abr; Abar[pp * 2 + 1] = abi;
    float xr = abr, xi = abi;
#pragma unroll
    for (int i = 0; i < 6; ++i) { float t = xr * xr - xi * xi; xi = 2.f * xr * xi; xr = t; }
    A64[pp * 2] = xr; A64[pp * 2 + 1] = xi;
  }
  for (int hh = sub * 4; hh < sub * 4 + 4; ++hh) {
    size_t bi = ((size_t)(l * 16 + g) * 64 + pp) * 16 + hh;
    float bre = p.in[I_S5_BRE][bi], bim = p.in[I_S5_BIM][bi];
    Bb[pp * 32 + hh] = f2bf(fr_ * bre - fi_ * bim);
    Bb[(64 + pp) * 32 + hh] = f2bf(fr_ * bim + fi_ * bre);
    Bb[pp * 32 + 16 + hh] = 0;
    Bb[(64 + pp) * 32 + 16 + hh] = 0;
  }
  for (int hh = sub * 4; hh < sub * 4 + 4; ++hh) {
    size_t ci = ((size_t)(l * 16 + g) * 16 + hh) * 64 + pp;
    Cm[hh * 128 + pp] = f2bf(p.in[I_S5_CRE][ci]);
    Cm[hh * 128 + 64 + pp] = f2bf(-p.in[I_S5_CIM][ci]);
  }
}

__device__ __forceinline__ void cvt_bf16_rows(const Params& p, const float* src, u16* dst, size_t n4) {
  for (size_t i = (size_t)blockIdx.x * 256 + tidx(); i < n4; i += (size_t)gridDim.x * 256) {
    float4 v = ((const float4*)src)[i];
    uint2 o;
    o.x = (unsigned)f2bf(v.x) | ((unsigned)f2bf(v.y) << 16);
    o.y = (unsigned)f2bf(v.z) | ((unsigned)f2bf(v.w) << 16);
    if (!p.dry) ((uint2*)dst)[i] = o;
  }
}
__device__ __forceinline__ void phase0(const Params& p, unsigned char* smem) {
  float* tile = (float*)smem;
  cvt_bf16_rows(p, p.in[I_X], (u16*)(p.ws + OFF_PREP), (size_t)NTOK * 1024 / 4);
  cvt_bf16_rows(p, p.in[I_MEM], (u16*)(p.ws + OFF_MEMB), (size_t)1024 * 1024 / 4);
  const int T_WIN = 1 * 64 * 16, T_WOUT = 4 * 16 * 20, T_GLU = 4 * 8 * 4, T_MKV = 4 * 8 * 16, T_S5 = 64;
  const int total = T_WIN + T_WOUT + T_GLU + T_MKV + T_S5;
  for (int it = blockIdx.x; it < total; it += gridDim.x) {
    int t = it;
    if (t < T_WIN) {
      int l = t / 1024, r = t % 1024, nt = r / 16, kt = r % 16;
      const float* src = (l == 0) ? p.in[I_WIN0] : p.in[I_WINR] + (size_t)(l - 1) * 1024 * 4020;
      tconv_tile(src, l == 0 ? 3988 : 4020, (u16*)(p.ws + OFF_WIN), 1024, nt * 64, kt * 64, 0, l, tile);
      continue;
    }
    t -= T_WIN;
    if (t < T_WOUT) {
      int l = t / 320, r = t % 320, nt = r / 20, kt = r % 20;
      tconv_tile(p.in[I_WOUT] + (size_t)l * 1280 * 1024, 1024, (u16*)(p.ws + OFF_WOUT) + (size_t)l * 1024 * 1280, 1280, nt * 64, kt * 64, 1, l, tile);
      continue;
    }
    t -= T_WOUT;
    if (t < T_GLU) {
      int l = t / 32, r = t % 32, nt = r / 4, kt = r % 4;
      tconv_tile(p.in[I_S5_GLUW] + (size_t)l * 256 * 512, 512, (u16*)(p.ws + OFF_GLU) + (size_t)l * 512 * 256, 256, nt * 64, kt * 64, 2, l, tile);
      continue;
    }
    t -= T_GLU;
    if (t < T_MKV) {
      int l = t / 128, r = t % 128, nt = r / 16, kt = r % 16;
      tconv_tile(p.in[I_MEM_WKV] + (size_t)l * 1024 * 512, 512, (u16*)(p.ws + OFF_MKV) + (size_t)l * 512 * 1024, 1024, nt * 64, kt * 64, 1, l, tile);
      continue;
    }
    t -= T_MKV;
    s5_params_item(p, t / 16, t % 16);
  }
  {
    u16* W2T = (u16*)(p.ws + OFF_W2T);
    u16* A2T = (u16*)(p.ws + OFF_A2T);
    u16* V2T = (u16*)(p.ws + OFF_V2T);
    for (int i = blockIdx.x * 256 + tidx(); i < 4 * 256 * 64; i += gridDim.x * 256) {
      const int ll = i >> 14, cc = (i >> 6) & 255, j = i & 63;
      if (!p.dry) {
        const float wv_ = p.in[I_RW_W2][((size_t)ll * 64 + j) * 256 + cc];
        const u16 wh_ = f2bf(wv_);
        W2T[i] = wh_;
        ((u16*)(p.ws + OFF_W2L))[i] = f2bf(wv_ - bf2f(wh_));
        A2T[i] = f2bf(p.in[I_RW_A2][((size_t)ll * 64 + j) * 256 + cc]);
      }
    }
    for (int i = blockIdx.x * 256 + tidx(); i < 3 * 256 * 32; i += gridDim.x * 256) {
      const int ll = i >> 13, cc = (i >> 5) & 255, j = i & 31;
      if (!p.dry) V2T[i] = f2bf(p.in[I_RW_V2][((size_t)ll * 32 + j) * 256 + cc]);
    }
  }
}

__device__ __forceinline__ void phaseA(const Params& p, int l, unsigned char* smem) {
  const int T_IN = 256 * 16, T_KV = (l == 0) ? 4 * 8 * 2 : 0;
  for (int it = blockIdx.x; it < T_IN + T_KV; it += gridDim.x) {
    if (it < T_IN) {
      int mt = it / 16, nt = it % 16;
      if (gridDim.x == 512) {
        const int r = it >> 9, x = blockIdx.x & 7, k = blockIdx.x >> 3;
        mt = x * 32 + (r >> 1) * 8 + (k >> 3);
        nt = (r & 1) * 8 + (k & 7);
      }
      gemm_tile<EPI_P, false>(p, l, (const u16*)(p.ws + OFF_PREP), 1024, (const u16*)(p.ws + OFF_WIN), 1024, mt * 128, nt * 256, smem);
    } else {
      int t = it - T_IN, ll = t >> 4, mt = (t & 15) / 2, nt = t & 1;
      gemm_tile<EPI_MEMKV, false>(p, ll, (const u16*)(p.ws + OFF_MEMB), 1024, (const u16*)(p.ws + OFF_MKV) + (size_t)ll * 512 * 1024, 1024, mt * 128, nt * 256, smem);
    }
  }
}

template <bool OUT>
__device__ __forceinline__ void gla_item(const Params& p, int l, int b, int c, int h, unsigned char* smem) {
  u16* P = (u16*)(p.ws + OFF_P);
  const int tid = tidx(), lane = tid & 63, w = tid >> 6, fr = lane & 15, fq = lane >> 4;
  const int kc = lane, sq = w;
  u16* t0 = (u16*)smem;
  u16* t1 = t0 + 64 * 72;
  u16* t2 = t1 + 64 * 72;
  u16* t3 = t2 + 64 * 72;
  u16* t4 = t3 + 64 * 72;
  float* tot = (float*)(t4 + 64 * 72);
  const size_t tok0 = (size_t)b * SEQ + c * 64;
  u16* gst = (u16*)(p.ws + OFF_GST) + ((size_t)((b * 128 + c) * 4 + h)) * 4096;
  __syncthreads();
  unsigned qraw[16], kraw[16], vraw16[16];
#pragma unroll
  for (int i = 0; i < 16; ++i) {
    const size_t tok = tok0 + sq * 16 + i;
    kraw[i] = P[tok * PC + C_GK + h * 64 + kc];
    vraw16[i] = P[tok * PC + C_GV + h * 64 + kc];
    qraw[i] = OUT ? (unsigned)P[tok * PC + C_GQ + h * 64 + kc] : 0u;
  }
  uint4 spv0 = make_uint4(0, 0, 0, 0), spv1 = spv0;
  uint2 gq4[4];
  if (OUT) {
    spv0 = *(const uint4*)(gst + tid * 8);
    spv1 = *(const uint4*)(gst + (tid + 256) * 8);
#pragma unroll
    for (int n = 0; n < 4; ++n) gq4[n] = *(const uint2*)(P + (tok0 + w * 16 + fr) * PC + h * 64 + n * 16 + fq * 4);
  }
  float wa[16];
#pragma unroll
  for (int r = 0; r < 16; ++r) wa[r] = p.in[I_GLA_WA2][(size_t)(l * 16 + r) * 256 + h * 64 + kc];
  const float ba = p.in[I_GLA_BA][l * 256 + h * 64 + kc];
  float bc[16];
  float run = 0.f;
#pragma unroll
  for (int i = 0; i < 16; ++i) {
    size_t tok = tok0 + sq * 16 + i;
    const uint4* ap = (const uint4*)(P + tok * PC + C_GA);
    uint4 a0 = ap[0], a1 = ap[1];
    unsigned aw[8] = {a0.x, a0.y, a0.z, a0.w, a1.x, a1.y, a1.z, a1.w};
    float z = ba;
#pragma unroll
    for (int r = 0; r < 8; ++r) {
      z += bf2f((u16)(aw[r] & 0xffff)) * wa[2 * r];
      z += bf2f((u16)(aw[r] >> 16)) * wa[2 * r + 1];
    }
    float la = -(fmaxf(-z, 0.f) + __logf(1.f + __expf(-fabsf(z)))) * (1.f / 16.f);
    run += la;
    bc[i] = run;
  }
  tot[sq * 64 + kc] = run;
  __syncthreads();
  float prefix = 0.f, blast = 0.f;
#pragma unroll
  for (int q = 0; q < 4; ++q) {
    float t = tot[q * 64 + kc];
    if (q < sq) prefix += t;
    blast += t;
  }
  unsigned vpk[8], kpk[8];
#pragma unroll
  for (int i = 0; i < 8; ++i) { vpk[i] = 0u; kpk[i] = 0u; }
#pragma unroll
  for (int i = 0; i < 16; ++i) {
    int s = sq * 16 + i;
    size_t tok = tok0 + s;
    float bcum = bc[i] + prefix;
    float kv = bf2f((u16)kraw[i]);
    vpk[i >> 1] |= vraw16[i] << (16 * (i & 1));
    if (OUT) {
      float qv = bf2f((u16)qraw[i]) * 0.125f;
      t0[s * 72 + kc] = f2bf(qv * __expf(bcum));
      t1[s * 72 + kc] = f2bf(kv * __expf(-bcum));
    } else {
      kpk[i >> 1] |= (unsigned)f2bf(kv * __expf(blast - bcum)) << (16 * (i & 1));
    }
  }
  *(uint4*)(t2 + kc * 72 + sq * 16) = make_uint4(vpk[0], vpk[1], vpk[2], vpk[3]);
  *(uint4*)(t2 + kc * 72 + sq * 16 + 8) = make_uint4(vpk[4], vpk[5], vpk[6], vpk[7]);
  if (!OUT) {
    *(uint4*)(t0 + kc * 72 + sq * 16) = make_uint4(kpk[0], kpk[1], kpk[2], kpk[3]);
    *(uint4*)(t0 + kc * 72 + sq * 16 + 8) = make_uint4(kpk[4], kpk[5], kpk[6], kpk[7]);
  }
  if (!OUT) {
    if (!p.dry) { if (sq == 0) ((float*)(p.ws + OFF_GDC))[((size_t)((b * 128 + c) * 4 + h)) * 64 + kc] = __expf(blast); }
  } else {
    *(uint4*)(t4 + (tid >> 3) * 72 + (tid & 7) * 8) = spv0;
    *(uint4*)(t4 + ((tid + 256) >> 3) * 72 + (tid & 7) * 8) = spv1;
  }
  __syncthreads();
  f32x4 acc[4];
#pragma unroll
  for (int n = 0; n < 4; ++n) acc[n] = f32x4{0.f, 0.f, 0.f, 0.f};
  if (!OUT) {
    mma_strip_t<4, 2>(t2 + (w * 16) * 72, 72, t0, 72, acc);
    if (!p.dry) {
#pragma unroll
      for (int n = 0; n < 4; ++n)
        *(uint2*)(gst + (w * 16 + fr) * 64 + n * 16 + fq * 4) = pack4(acc[n][0], acc[n][1], acc[n][2], acc[n][3]);
    }
    return;
  }
  const int lrow = w * 16 + fr;
  mma_strip_t<4, 2>(t0 + (w * 16) * 72, 72, t1, 72, acc);
#pragma unroll
  for (int n = 0; n < 4; ++n) {
    const int sb = n * 16 + fq * 4;
    *(uint2*)(t3 + lrow * 72 + sb) = pack4(sb <= lrow ? acc[n][0] : 0.f, sb + 1 <= lrow ? acc[n][1] : 0.f,
                                           sb + 2 <= lrow ? acc[n][2] : 0.f, sb + 3 <= lrow ? acc[n][3] : 0.f);
  }
  __syncthreads();
  f32x4 o[4];
#pragma unroll
  for (int n = 0; n < 4; ++n) o[n] = f32x4{0.f, 0.f, 0.f, 0.f};
  mma_strip_t<4, 2>(t3 + (w * 16) * 72, 72, t2, 72, o);
  mma_strip_t<4, 2>(t0 + (w * 16) * 72, 72, t4, 72, o);
  const float* nw = p.in[I_GLA_NW] + l * 256 + h * 64;
  float ss = 0.f;
#pragma unroll
  for (int n = 0; n < 4; ++n)
#pragma unroll
    for (int j = 0; j < 4; ++j) ss += o[n][j] * o[n][j];
  ss += __shfl_xor(ss, 16, 64);
  ss += __shfl_xor(ss, 32, 64);
  const float sc = rsqrtf(ss * (1.f / 64.f) + 1e-6f);
  const size_t tok = tok0 + lrow;
#pragma unroll
  for (int n = 0; n < 4; ++n) {
    const int v0 = n * 16 + fq * 4;
    uint2* gp = (uint2*)(P + tok * PC + h * 64 + v0);
    float g[4];
    unpack4(gq4[n], g);
    const float4 nv = *(const float4*)(nw + v0);
    if (!p.dry) *gp = pack4(o[n][0] * sc * nv.x * silu(g[0]), o[n][1] * sc * nv.y * silu(g[1]),
                            o[n][2] * sc * nv.z * silu(g[2]), o[n][3] * sc * nv.w * silu(g[3]));
  }
}

template <bool OUT>
__device__ __forceinline__ void ssd_item(const Params& p, int l, int b, int c, int h, unsigned char* smem) {
  u16* P = (u16*)(p.ws + OFF_P);
  const int tid = tidx(), lane = tid & 63, w = tid >> 6, fr = lane & 15, fq = lane >> 4;
  const int ch = lane, sq = w, g = h >> 1;
  u16* t0 = (u16*)smem;
  u16* t1 = t0 + 64 * 72;
  u16* t2 = t1 + 64 * 72;
  u16* t3 = t2 + 64 * 72;
  u16* t4 = t3 + 64 * 72;
  float* dts = (float*)(t4 + 64 * 72);
  float* acs = dts + 64;
  const size_t tok0 = (size_t)b * SEQ + c * 64;
  u16* sst = (u16*)(p.ws + OFF_SST) + ((size_t)((b * 128 + c) * 4 + h)) * 4096;
  __syncthreads();
  const int colx = C_XBC + h * 64 + ch, colb = C_XBC + 256 + g * 64 + ch, colc = C_XBC + 384 + g * 64 + ch;
  const int s0 = sq * 16;
  unsigned xr[19], br[19], cr[19];
#pragma unroll
  for (int j = 0; j < 19; ++j) {
    const int t = c * 64 + s0 - 3 + j;
    if (t >= 0) {
      const size_t tok = (size_t)b * SEQ + t;
      xr[j] = P[tok * PC + colx]; br[j] = P[tok * PC + colb]; cr[j] = P[tok * PC + colc];
    } else { xr[j] = 0u; br[j] = 0u; cr[j] = 0u; }
  }
  uint4 spv0 = make_uint4(0, 0, 0, 0), spv1 = spv0;
  uint2 gq4[4];
  if (OUT) {
    spv0 = *(const uint4*)(sst + tid * 8);
    spv1 = *(const uint4*)(sst + (tid + 256) * 8);
#pragma unroll
    for (int n = 0; n < 4; ++n) gq4[n] = *(const uint2*)(P + (tok0 + w * 16 + fr) * PC + 256 + h * 64 + n * 16 + fq * 4);
  }
  if (tid < 64) {
    float raw = bf2f(P[(tok0 + tid) * PC + C_DT + h]) + p.in[I_SSD_DTB][l * 4 + h];
    const float dtv = softplus(raw);
    dts[tid] = dtv;
    float x = dtv * -expf(p.in[I_SSD_ALOG][l * 4 + h]);
#pragma unroll
    for (int d = 1; d < 64; d <<= 1) {
      const float y = __shfl_up(x, d, 64);
      if (lane >= d) x += y;
    }
    acs[tid] = x;
  }
  __syncthreads();
  const float alast = acs[63];
  const int cix = h * 64 + ch, cib = 256 + g * 64 + ch, cic = 384 + g * 64 + ch;
  const float* cw = p.in[I_SSD_CW] + (size_t)l * 4 * 512;
  const float* cb = p.in[I_SSD_CB] + l * 512;
  float wx[4], wb[4], wcc[4];
#pragma unroll
  for (int j = 0; j < 4; ++j) { wx[j] = cw[j * 512 + cix]; wb[j] = cw[j * 512 + cib]; wcc[j] = cw[j * 512 + cic]; }
  const float bx = cb[cix], bb = cb[cib], bcv = cb[cic];
  float hx[3], hb[3], hc[3];
  unsigned pk0[8], pk1[8];
#pragma unroll
  for (int i = 0; i < 8; ++i) { pk0[i] = 0u; pk1[i] = 0u; }
#pragma unroll
  for (int j = 0; j < 3; ++j) { hx[j] = bf2f((u16)xr[j]); hb[j] = bf2f((u16)br[j]); hc[j] = bf2f((u16)cr[j]); }
#pragma unroll
  for (int i = 0; i < 16; ++i) {
    int s = s0 + i;
    float cx = bf2f((u16)xr[i + 3]), cbv = bf2f((u16)br[i + 3]), ccv = bf2f((u16)cr[i + 3]);
    float xs = silu(wx[0] * hx[0] + wx[1] * hx[1] + wx[2] * hx[2] + wx[3] * cx + bx);
    float bm = silu(wb[0] * hb[0] + wb[1] * hb[1] + wb[2] * hb[2] + wb[3] * cbv + bb);
    float cm = silu(wcc[0] * hc[0] + wcc[1] * hc[1] + wcc[2] * hc[2] + wcc[3] * ccv + bcv);
    hx[0] = hx[1]; hx[1] = hx[2]; hx[2] = cx;
    hb[0] = hb[1]; hb[1] = hb[2]; hb[2] = cbv;
    hc[0] = hc[1]; hc[1] = hc[2]; hc[2] = ccv;
    float dt = dts[s];
    if (OUT) {
      t0[s * 72 + ch] = f2bf(cm);
      t1[s * 72 + ch] = f2bf(bm);
      pk0[i >> 1] |= (unsigned)f2bf(xs * dt) << (16 * (i & 1));
      t4[s * 72 + ch] = f2bf(xs);
    } else {
      pk0[i >> 1] |= (unsigned)f2bf(bm) << (16 * (i & 1));
      pk1[i >> 1] |= (unsigned)f2bf(xs * dt * __expf(alast - acs[s])) << (16 * (i & 1));
    }
  }
  if (OUT) {
    *(uint4*)(t2 + ch * 72 + s0) = make_uint4(pk0[0], pk0[1], pk0[2], pk0[3]);
    *(uint4*)(t2 + ch * 72 + s0 + 8) = make_uint4(pk0[4], pk0[5], pk0[6], pk0[7]);
  } else {
    *(uint4*)(t0 + ch * 72 + s0) = make_uint4(pk0[0], pk0[1], pk0[2], pk0[3]);
    *(uint4*)(t0 + ch * 72 + s0 + 8) = make_uint4(pk0[4], pk0[5], pk0[6], pk0[7]);
    *(uint4*)(t1 + ch * 72 + s0) = make_uint4(pk1[0], pk1[1], pk1[2], pk1[3]);
    *(uint4*)(t1 + ch * 72 + s0 + 8) = make_uint4(pk1[4], pk1[5], pk1[6], pk1[7]);
  }
  if (!OUT) {
    if (!p.dry) { if (sq == 0) ((float*)(p.ws + OFF_SDC))[((size_t)((b * 128 + c) * 4 + h)) * 64 + ch] = __expf(alast); }
  } else {
    *(uint4*)(t3 + (tid >> 3) * 72 + (tid & 7) * 8) = spv0;
    *(uint4*)(t3 + ((tid + 256) >> 3) * 72 + (tid & 7) * 8) = spv1;
  }
  __syncthreads();
  f32x4 acc[4];
#pragma unroll
  for (int n = 0; n < 4; ++n) acc[n] = f32x4{0.f, 0.f, 0.f, 0.f};
  if (!OUT) {
    mma_strip_t<4, 2>(t1 + (w * 16) * 72, 72, t0, 72, acc);
    if (!p.dry) {
#pragma unroll
      for (int n = 0; n < 4; ++n)
        *(uint2*)(sst + (w * 16 + fr) * 64 + n * 16 + fq * 4) = pack4(acc[n][0], acc[n][1], acc[n][2], acc[n][3]);
    }
    return;
  }
  const int lrow = w * 16 + fr;
  mma_strip_t<4, 2>(t0 + (w * 16) * 72, 72, t1, 72, acc);
  __syncthreads();
  {
    const float al = acs[lrow];
#pragma unroll
    for (int n = 0; n < 4; ++n) {
      const int sb = n * 16 + fq * 4;
      float v[4];
#pragma unroll
      for (int j = 0; j < 4; ++j) v[j] = (sb + j <= lrow) ? acc[n][j] * __expf(al - acs[sb + j]) : 0.f;
      *(uint2*)(t1 + lrow * 72 + sb) = pack4(v[0], v[1], v[2], v[3]);
    }
  }
  __syncthreads();
  f32x4 y[4], yi[4];
#pragma unroll
  for (int n = 0; n < 4; ++n) { y[n] = f32x4{0.f, 0.f, 0.f, 0.f}; yi[n] = f32x4{0.f, 0.f, 0.f, 0.f}; }
  mma_strip_t<4, 2>(t1 + (w * 16) * 72, 72, t2, 72, y);
  mma_strip_t<4, 2>(t0 + (w * 16) * 72, 72, t3, 72, yi);
  const float Dh = p.in[I_SSD_D][l * 4 + h];
  const float* nw = p.in[I_SSD_NW] + l * 256 + h * 64;
  const float ea = __expf(acs[lrow]);
  float vals[4][4];
  float ss = 0.f;
#pragma unroll
  for (int n = 0; n < 4; ++n) {
    float xv[4];
    unpack4(*(const uint2*)(t4 + lrow * 72 + n * 16 + fq * 4), xv);
#pragma unroll
    for (int j = 0; j < 4; ++j) {
      float v = y[n][j] + yi[n][j] * ea + Dh * xv[j];
      vals[n][j] = v;
      ss += v * v;
    }
  }
  ss += __shfl_xor(ss, 16, 64);
  ss += __shfl_xor(ss, 32, 64);
  const float sc = rsqrtf(ss * (1.f / 64.f) + 1e-6f);
  const size_t tok = tok0 + lrow;
#pragma unroll
  for (int n = 0; n < 4; ++n) {
    const int p0 = n * 16 + fq * 4;
    uint2* gp = (uint2*)(P + tok * PC + 256 + h * 64 + p0);
    float g[4];
    unpack4(gq4[n], g);
    const float4 nv = *(const float4*)(nw + p0);
    if (!p.dry) *gp = pack4(vals[n][0] * sc * nv.x * silu(g[0]), vals[n][1] * sc * nv.y * silu(g[1]),
                            vals[n][2] * sc * nv.z * silu(g[2]), vals[n][3] * sc * nv.w * silu(g[3]));
  }
}

__device__ __forceinline__ void state_scan_item(const Params& p, u16* st, const float* dc, int item) {
  const int tid = tidx();
  const int bh = item >> 3, b = bh >> 2, h = bh & 3;
  const int e = ((item & 7) * 256 + tid) * 2;
  float s0 = 0.f, s1 = 0.f;
#pragma unroll 1
  for (int c0 = 0; c0 < 128; c0 += 8) {
    unsigned cv[8];
    float2 dv[8];
#pragma unroll
    for (int i = 0; i < 8; ++i) {
      size_t base = (size_t)((b * 128 + c0 + i) * 4 + h);
      cv[i] = *(const unsigned*)(st + base * 4096 + e);
      dv[i] = *(const float2*)(dc + base * 64 + (e & 63));
    }
#pragma unroll
    for (int i = 0; i < 8; ++i) {
      size_t base = (size_t)((b * 128 + c0 + i) * 4 + h);
      if (!p.dry) { *(unsigned*)(st + base * 4096 + e) = (unsigned)f2bf(s0) | ((unsigned)f2bf(s1) << 16); }
      s0 = dv[i].x * s0 + __uint_as_float(cv[i] << 16);
      s1 = dv[i].y * s1 + __uint_as_float(cv[i] & 0xffff0000u);
    }
  }
}

template <bool OUT>
__device__ __forceinline__ void s5_item(const Params& p, int l, int b, int c, unsigned char* smem) {
  u16* P = (u16*)(p.ws + OFF_P);
  const int tid = tidx(), lane = tid & 63, w = tid >> 6, fr = lane & 15, fq = lane >> 4;
  float* Bu = (float*)smem + w * (16 * 132);
  const size_t tok0 = (size_t)b * SEQ + c * 64;
  __syncthreads();
  for (int gi = 0; gi < 4; ++gi) {
    const int g = gi * 4 + w;
    const float* Ab = (const float*)(p.ws + OFF_S5A) + ((size_t)(l * 16 + g) * 64) * 2;
    const u16* Bb = (const u16*)(p.ws + OFF_S5B) + (size_t)(l * 16 + g) * 128 * 32;
    const u16* Cm = (const u16*)(p.ws + OFF_S5C) + (size_t)(l * 16 + g) * 16 * 128;
    float* xs = (float*)(p.ws + OFF_S5X) + (((size_t)(b * 128 + c) * 16 + g) * 64) * 2;
    const float ar = Ab[lane * 2], ai = Ab[lane * 2 + 1];
    float xr = 0.f, xi = 0.f;
    if (OUT) { xr = xs[lane * 2]; xi = xs[lane * 2 + 1]; }
    const float Dv = p.in[I_S5_D][l * 256 + g * 16 + fr];
    for (int mt = 0; mt < 4; ++mt) {
      bf16x8 a = bf16x8{0, 0, 0, 0, 0, 0, 0, 0};
      if (fq < 2) a = *(const bf16x8*)(P + (tok0 + mt * 16 + fr) * PC + C_S5U + g * 16 + fq * 8);
#pragma unroll
      for (int nt = 0; nt < 8; ++nt) {
        bf16x8 bb = *(const bf16x8*)(Bb + (nt * 16 + fr) * 32 + fq * 8);
        f32x4 r = __builtin_amdgcn_mfma_f32_16x16x32_bf16(a, bb, f32x4{0.f, 0.f, 0.f, 0.f}, 0, 0, 0);
#pragma unroll
        for (int j = 0; j < 4; ++j) Bu[(fq * 4 + j) * 132 + nt * 16 + fr] = r[j];
      }
      __syncthreads();
      for (int t = 0; t < 16; ++t) {
        float bre = Bu[t * 132 + lane], bim = Bu[t * 132 + 64 + lane];
        float nr = ar * xr - ai * xi + bre;
        float ni = ar * xi + ai * xr + bim;
        xr = nr; xi = ni;
        if (OUT) {
          u16* X = (u16*)(Bu + t * 132);
          X[lane] = f2bf(xr);
          X[64 + lane] = f2bf(xi);
        }
      }
      __syncthreads();
      if (OUT) {
        f32x4 ya[1];
        ya[0] = f32x4{0.f, 0.f, 0.f, 0.f};
        mma_strip<1, 4>((const u16*)Bu, 264, Cm, 128, ya);
#pragma unroll
        for (int j = 0; j < 4; ++j) {
          size_t a_ = (tok0 + mt * 16 + fq * 4 + j) * PC + C_S5U + g * 16 + fr;
          float uval = bf2f(P[a_]);
          float yv = ya[0][j] + Dv * uval;
          if (!p.dry) { P[a_] = f2bf(gelu_tanh(yv)); }
        }
        __syncthreads();
      }
    }
    if (!p.dry) { if (!OUT) { xs[lane * 2] = xr; xs[lane * 2 + 1] = xi; } }
  }
}

__device__ __forceinline__ void s5_scan_item(const Params& p, int l, int item) {
  const int sidx = item * 256 + tidx();
  const int b = sidx >> 10, gp = sidx & 1023;
  const float* A64 = (const float*)(p.ws + OFF_S5A64) + ((size_t)l * 1024 + gp) * 2;
  const float ar = A64[0], ai = A64[1];
  float2* xs = (float2*)(p.ws + OFF_S5X);
  float xr = 0.f, xi = 0.f;
#pragma unroll 1
  for (int c0 = 0; c0 < 128; c0 += 8) {
    float2 v[8];
#pragma unroll
    for (int i = 0; i < 8; ++i) v[i] = xs[(size_t)(b * 128 + c0 + i) * 1024 + gp];
#pragma unroll
    for (int i = 0; i < 8; ++i) {
      if (!p.dry) { xs[(size_t)(b * 128 + c0 + i) * 1024 + gp] = make_float2(xr, xi); }
      float nr = ar * xr - ai * xi + v[i].x;
      float ni = ar * xi + ai * xr + v[i].y;
      xr = nr; xi = ni;
    }
  }
}

__device__ __forceinline__ void rwkv_prep_item(const Params& p, int l, int item, unsigned char* smem) {
  u16* P = (u16*)(p.ws + OFF_P);
  const int tid = tidx(), lane = tid & 63, w = tid >> 6, fr = lane & 15, fq = lane >> 4;
  u16* Aw = (u16*)smem;
  u16* Aa = Aw + 16 * 72;
  u16* Av = Aa + 16 * 72;
  u16* Awl = Av + 16 * 40;
  const size_t tok0 = (size_t)item * 16;
  const float* mu = p.in[I_RW_MU] + l * 896;
  __syncthreads();
  for (int idx = tid; idx < 160 * 16; idx += 256) {
    int t = idx / 160, j = idx % 160;
    size_t tok = tok0 + t;
    if (j < 128) {
      int col = C_RW + 768 + j;
      float cur = bf2f(P[tok * PC + col]);
      float prev = ((tok & (SEQ - 1)) != 0) ? bf2f(P[(tok - 1) * PC + col]) : 0.f;
      float val = cur + (prev - cur) * mu[768 + j];
      if (j < 64) {
        const float th = 1.f - 2.f / (1.f + __expf(2.f * val));
        const u16 hi = f2bf(th);
        Aw[t * 72 + j] = hi;
        Awl[t * 72 + j] = f2bf(th - bf2f(hi));
      }
      else Aa[t * 72 + j - 64] = f2bf(val);
    } else {
      Av[t * 40 + j - 128] = P[tok * PC + C_VL + j - 128];
    }
  }
  __syncthreads();
  f32x4 accw[4], acca[4], accv[4];
#pragma unroll
  for (int n = 0; n < 4; ++n) { accw[n] = f32x4{0.f, 0.f, 0.f, 0.f}; acca[n] = accw[n]; accv[n] = accw[n]; }
  mma_strip_t<4, 2>(Aw, 72, (const u16*)(p.ws + OFF_W2T) + ((size_t)l * 256 + w * 64) * 64, 64, accw);
  mma_strip_t<4, 2>(Awl, 72, (const u16*)(p.ws + OFF_W2T) + ((size_t)l * 256 + w * 64) * 64, 64, accw);
  mma_strip_t<4, 2>(Aw, 72, (const u16*)(p.ws + OFF_W2L) + ((size_t)l * 256 + w * 64) * 64, 64, accw);
  mma_strip_t<4, 2>(Aa, 72, (const u16*)(p.ws + OFF_A2T) + ((size_t)l * 256 + w * 64) * 64, 64, acca);
  if (l > 0) mma_strip_t<4, 1>(Av, 40, (const u16*)(p.ws + OFF_V2T) + ((size_t)(l - 1) * 256 + w * 64) * 32, 32, accv);
  u16* R = (u16*)(p.ws + OFF_PREP);
  u16* Kp = R + (size_t)NTOK * 256;
  u16* V = Kp + (size_t)NTOK * 256;
  u16* KK = V + (size_t)NTOK * 256;
  u16* BV = KK + (size_t)NTOK * 256;
  u16* LW = BV + (size_t)NTOK * 256;
  u16* VF = (u16*)(p.ws + OFF_VF);
  const size_t tok = tok0 + fr;
  const bool hasprev = (tok & (SEQ - 1)) != 0;
  float kkv[4][4], av[4][4], kx[4][4];
  float ss = 0.f;
#pragma unroll
  for (int n = 0; n < 4; ++n) {
    const int cb = w * 64 + n * 16 + fq * 4;
    float kc_[4], kp_[4] = {0.f, 0.f, 0.f, 0.f};
    unpack4(*(const uint2*)(P + tok * PC + C_RW + 256 + cb), kc_);
    if (hasprev) unpack4(*(const uint2*)(P + (tok - 1) * PC + C_RW + 256 + cb), kp_);
    const float4 muk = *(const float4*)(mu + 256 + cb);
    const float4 kkw = *(const float4*)(p.in[I_RW_KK] + l * 256 + cb);
    const float4 a0 = *(const float4*)(p.in[I_RW_A0] + l * 256 + cb);
    const float mk[4] = {muk.x, muk.y, muk.z, muk.w}, kw[4] = {kkw.x, kkw.y, kkw.z, kkw.w}, a0v[4] = {a0.x, a0.y, a0.z, a0.w};
#pragma unroll
    for (int j = 0; j < 4; ++j) {
      const float k = kc_[j] + (kp_[j] - kc_[j]) * mk[j];
      kx[n][j] = k;
      const float kk = k * kw[j];
      kkv[n][j] = kk;
      ss += kk * kk;
      av[n][j] = sigm(a0v[j] + acca[n][j]);
    }
  }
  ss += __shfl_xor(ss, 16, 64);
  ss += __shfl_xor(ss, 32, 64);
  const float kn = rsqrtf(ss + 1e-12f);
#pragma unroll
  for (int n = 0; n < 4; ++n) {
    const int cb = w * 64 + n * 16 + fq * 4;
    float rc[4], rp[4] = {0.f, 0.f, 0.f, 0.f}, vc[4], vp[4] = {0.f, 0.f, 0.f, 0.f};
    unpack4(*(const uint2*)(P + tok * PC + C_RW + cb), rc);
    unpack4(*(const uint2*)(P + tok * PC + C_RW + 512 + cb), vc);
    if (hasprev) {
      unpack4(*(const uint2*)(P + (tok - 1) * PC + C_RW + cb), rp);
      unpack4(*(const uint2*)(P + (tok - 1) * PC + C_RW + 512 + cb), vp);
    }
    const float4 mur = *(const float4*)(mu + cb);
    const float4 muv = *(const float4*)(mu + 512 + cb);
    const float4 w0 = *(const float4*)(p.in[I_RW_W0] + l * 256 + cb);
    const float4 kaw = *(const float4*)(p.in[I_RW_KA] + l * 256 + cb);
    const float mr[4] = {mur.x, mur.y, mur.z, mur.w}, mv[4] = {muv.x, muv.y, muv.z, muv.w};
    const float w0v[4] = {w0.x, w0.y, w0.z, w0.w}, kav[4] = {kaw.x, kaw.y, kaw.z, kaw.w};
    float vfv[4] = {0.f, 0.f, 0.f, 0.f}, v0v[4] = {0.f, 0.f, 0.f, 0.f};
    if (l > 0) {
      unpack4(*(const uint2*)(VF + tok * 256 + cb), vfv);
      const float4 v0 = *(const float4*)(p.in[I_RW_V0] + (l - 1) * 256 + cb);
      v0v[0] = v0.x; v0v[1] = v0.y; v0v[2] = v0.z; v0v[3] = v0.w;
    }
    float ro[4], ko[4], vo[4], kko[4], bo[4], lo[4];
#pragma unroll
    for (int j = 0; j < 4; ++j) {
      ro[j] = rc[j] + (rp[j] - rc[j]) * mr[j];
      float v = vc[j] + (vp[j] - vc[j]) * mv[j];
      if (l > 0) v = v + (vfv[j] - v) * sigm(v0v[j] + accv[n][j]);
      vo[j] = v;
      const float wraw = -softplus(-(w0v[j] + accw[n][j])) - 0.5f;
      lo[j] = -__expf(wraw);
      const float a = av[n][j];
      const float kk = kkv[n][j] * kn;
      kko[j] = kk;
      bo[j] = kk * a;
      ko[j] = kx[n][j] * (1.f + (a - 1.f) * kav[j]);
    }
    if (!p.dry) {
      const size_t o = tok * 256 + cb;
      if (l == 0) *(uint2*)(VF + o) = pack4(vo[0], vo[1], vo[2], vo[3]);
      *(uint2*)(R + o) = pack4(ro[0], ro[1], ro[2], ro[3]);
      *(uint2*)(Kp + o) = pack4(ko[0], ko[1], ko[2], ko[3]);
      *(uint2*)(V + o) = pack4(vo[0], vo[1], vo[2], vo[3]);
      *(uint2*)(KK + o) = pack4(kko[0], kko[1], kko[2], kko[3]);
      *(uint2*)(BV + o) = pack4(bo[0], bo[1], bo[2], bo[3]);
      *(uint2*)(LW + o) = pack4(lo[0], lo[1], lo[2], lo[3]);
    }
  }
}

typedef float f2 __attribute__((ext_vector_type(2)));
__device__ __forceinline__ float dpp_xor1(float v) { return __int_as_float(__builtin_amdgcn_update_dpp(0, __float_as_int(v), 0xB1, 0xf, 0xf, false)); }
__device__ __forceinline__ float dpp_xor2(float v) { return __int_as_float(__builtin_amdgcn_update_dpp(0, __float_as_int(v), 0x4E, 0xf, 0xf, false)); }
__device__ __forceinline__ void unpack8(const uint4& u, float* o) {
  o[0] = __uint_as_float(u.x << 16); o[1] = __uint_as_float(u.x & 0xffff0000u);
  o[2] = __uint_as_float(u.y << 16); o[3] = __uint_as_float(u.y & 0xffff0000u);
  o[4] = __uint_as_float(u.z << 16); o[5] = __uint_as_float(u.z & 0xffff0000u);
  o[6] = __uint_as_float(u.w << 16); o[7] = __uint_as_float(u.w & 0xffff0000u);
}
__device__ __forceinline__ void stage8(float* dst, const uint4& u, bool do_exp) {
  float o[8];
  unpack8(u, o);
  if (do_exp) {
#pragma unroll
    for (int i = 0; i < 8; ++i) o[i] = __expf(o[i]);
  }
  ((float4*)dst)[0] = make_float4(o[0], o[1], o[2], o[3]);
  ((float4*)dst)[1] = make_float4(o[4], o[5], o[6], o[7]);
}
template <int PASS, bool USEV>
__device__ __forceinline__ void rwkv_scan_wave(const Params& p, int l, int wi, float* lds) {
  u16* P = (u16*)(p.ws + OFF_P);
  const int lane = tidx() & 63, rg = lane >> 2, q = lane & 3;
  int which = 0, seg, bh;
  if (PASS == 1) { which = wi & 1; seg = (wi >> 1) % NSEG; bh = (wi >> 1) / NSEG; }
  else { seg = wi % NSEG; bh = wi / NSEG; }
  const int b = bh >> 2, h = bh & 3;
  float* sw = lds;
  float* skk = sw + 512;
  float* sb = skk + 512;
  float* sk = sb + 512;
  float* sv = sk + 512;
  float* sr = sv + 512;
  float* sy = sw;
  const u16* R = (const u16*)(p.ws + OFF_PREP);
  const u16* Kp = R + (size_t)NTOK * 256;
  const u16* V = Kp + (size_t)NTOK * 256;
  const u16* KK = V + (size_t)NTOK * 256;
  const u16* BV = KK + (size_t)NTOK * 256;
  const u16* LW = BV + (size_t)NTOK * 256;
  float* Sl = (float*)(p.ws + OFF_RSL) + ((size_t)(bh * NSEG + seg)) * 4096;
  float* Pm = (float*)(p.ws + OFF_RPM) + ((size_t)(bh * NSEG + seg)) * 4096;
  f2 e[4][8];
  if (PASS == 1) {
#pragma unroll
    for (int r = 0; r < 4; ++r)
#pragma unroll
      for (int j = 0; j < 8; ++j) {
        int row = rg * 4 + r, c0 = q * 16 + j * 2;
        e[r][j] = f2{(which == 1 && row == c0) ? 1.f : 0.f, (which == 1 && row == c0 + 1) ? 1.f : 0.f};
      }
  } else {
#pragma unroll
    for (int r = 0; r < 4; ++r)
#pragma unroll
      for (int i = 0; i < 4; ++i) {
        float4 v = *(const float4*)(Sl + (rg * 4 + r) * 64 + q * 16 + i * 4);
        e[r][i * 2] = f2{v.x, v.y};
        e[r][i * 2 + 1] = f2{v.z, v.w};
      }
  }
  constexpr bool usev = USEV;
  const int st = lane >> 3, sc8 = (lane & 7) * 8;
  const size_t g0 = ((size_t)b * SEQ + (size_t)seg * SEGLEN) * 256 + h * 64 + (size_t)st * 256 + sc8;
  float rkw[8], gnw[8], gnb[8];
  if (PASS == 3) {
#pragma unroll
    for (int i = 0; i < 8; ++i) {
      rkw[i] = p.in[I_RW_RK][l * 256 + h * 64 + sc8 + i];
      gnw[i] = p.in[I_RW_GNW][l * 256 + h * 64 + sc8 + i];
      gnb[i] = p.in[I_RW_GNB][l * 256 + h * 64 + sc8 + i];
    }
  }
  uint4 nlw, nkk, nb, nk, nv, nr;
  nv = make_uint4(0, 0, 0, 0);
  nr = nv;
#define RW_ISSUE(sc)                                              \
  {                                                               \
    const size_t gi = g0 + (size_t)(sc) * 8 * 256;                \
    nlw = *(const uint4*)(LW + gi);                               \
    nkk = *(const uint4*)(KK + gi);                               \
    nb = *(const uint4*)(BV + gi);                                \
    nk = *(const uint4*)(Kp + gi);                                \
    if (usev) nv = *(const uint4*)(V + gi);                       \
    if (PASS == 3) nr = *(const uint4*)(R + gi);                  \
  }
  RW_ISSUE(0);
#pragma unroll 1
  for (int sc = 0; sc < SEGLEN / 8; ++sc) {
    asm volatile("" ::: "memory");
    stage8(sw + st * 64 + sc8, nlw, true);
    stage8(skk + st * 64 + sc8, nkk, false);
    stage8(sb + st * 64 + sc8, nb, false);
    stage8(sk + st * 64 + sc8, nk, false);
    stage8(sv + st * 64 + sc8, nv, false);
    if (PASS == 3) stage8(sr + st * 64 + sc8, nr, false);
    if (sc + 1 < SEGLEN / 8) RW_ISSUE(sc + 1);
    __builtin_amdgcn_wave_barrier();
    asm volatile("" ::: "memory");
#pragma unroll 2
    for (int t = 0; t < 8; ++t) {
      f2 kk2[8], w2[8], b2[8], k2[8];
#pragma unroll
      for (int i = 0; i < 4; ++i) {
        float4 a = ((const float4*)(skk + t * 64 + q * 16))[i];
        kk2[i * 2] = f2{a.x, a.y}; kk2[i * 2 + 1] = f2{a.z, a.w};
        float4 c = ((const float4*)(sw + t * 64 + q * 16))[i];
        w2[i * 2] = f2{c.x, c.y}; w2[i * 2 + 1] = f2{c.z, c.w};
        float4 d = ((const float4*)(sb + t * 64 + q * 16))[i];
        b2[i * 2] = f2{d.x, d.y}; b2[i * 2 + 1] = f2{d.z, d.w};
        float4 g = ((const float4*)(sk + t * 64 + q * 16))[i];
        k2[i * 2] = f2{g.x, g.y}; k2[i * 2 + 1] = f2{g.z, g.w};
      }
      const float4 vv4 = *(const float4*)(sv + t * 64 + rg * 4);
      const float vvr[4] = {vv4.x, vv4.y, vv4.z, vv4.w};
      float sa[4];
#pragma unroll
      for (int r = 0; r < 4; ++r) {
        f2 acc = e[r][0] * kk2[0];
#pragma unroll
        for (int j = 1; j < 8; ++j) acc = e[r][j] * kk2[j] + acc;
        float part = acc.x + acc.y;
        part += dpp_xor1(part);
        part += dpp_xor2(part);
        sa[r] = -part;
      }
#pragma unroll
      for (int r = 0; r < 4; ++r) {
        const f2 sa2 = f2{sa[r], sa[r]};
        const f2 vv2 = f2{vvr[r], vvr[r]};
#pragma unroll
        for (int j = 0; j < 8; ++j) {
          f2 tnew = e[r][j] * w2[j];
          tnew = sa2 * b2[j] + tnew;
          if (USEV) tnew = vv2 * k2[j] + tnew;
          e[r][j] = tnew;
        }
      }
      if (PASS == 3) {
        f2 r2[8];
#pragma unroll
        for (int i = 0; i < 4; ++i) {
          float4 a = ((const float4*)(sr + t * 64 + q * 16))[i];
          r2[i * 2] = f2{a.x, a.y}; r2[i * 2 + 1] = f2{a.z, a.w};
        }
        float yv[4];
#pragma unroll
        for (int r = 0; r < 4; ++r) {
          f2 acc = e[r][0] * r2[0];
#pragma unroll
          for (int j = 1; j < 8; ++j) acc = e[r][j] * r2[j] + acc;
          float part = acc.x + acc.y;
          part += dpp_xor1(part);
          part += dpp_xor2(part);
          yv[r] = part;
        }
        if (q == 0) *(float4*)(sy + t * 64 + rg * 4) = make_float4(yv[0], yv[1], yv[2], yv[3]);
      }
    }
    if (PASS == 3) {
      __builtin_amdgcn_wave_barrier();
      asm volatile("" ::: "memory");
      float yv[8], rr[8], kx[8], vx[8];
#pragma unroll
      for (int i = 0; i < 2; ++i) {
        float4 a = ((const float4*)(sy + st * 64 + sc8))[i];
        yv[i * 4] = a.x; yv[i * 4 + 1] = a.y; yv[i * 4 + 2] = a.z; yv[i * 4 + 3] = a.w;
        float4 c = ((const float4*)(sr + st * 64 + sc8))[i];
        rr[i * 4] = c.x; rr[i * 4 + 1] = c.y; rr[i * 4 + 2] = c.z; rr[i * 4 + 3] = c.w;
        float4 d = ((const float4*)(sk + st * 64 + sc8))[i];
        kx[i * 4] = d.x; kx[i * 4 + 1] = d.y; kx[i * 4 + 2] = d.z; kx[i * 4 + 3] = d.w;
        float4 g = ((const float4*)(sv + st * 64 + sc8))[i];
        vx[i * 4] = g.x; vx[i * 4 + 1] = g.y; vx[i * 4 + 2] = g.z; vx[i * 4 + 3] = g.w;
      }
      float s1 = 0.f, bon = 0.f;
#pragma unroll
      for (int i = 0; i < 8; ++i) { s1 += yv[i]; bon += rr[i] * kx[i] * rkw[i]; }
#pragma unroll
      for (int m = 4; m >= 1; m >>= 1) { s1 += __shfl_xor(s1, m, 64); bon += __shfl_xor(bon, m, 64); }
      const float mean = s1 * (1.f / 64.f);
      float s2 = 0.f;
#pragma unroll
      for (int i = 0; i < 8; ++i) { float d = yv[i] - mean; s2 += d * d; }
#pragma unroll
      for (int m = 4; m >= 1; m >>= 1) s2 += __shfl_xor(s2, m, 64);
      const float rs = rsqrtf(s2 * (1.f / 64.f) + 64e-5f);
      const size_t tok = (size_t)b * SEQ + (size_t)seg * SEGLEN + sc * 8 + st;
      uint4* gp = (uint4*)(P + tok * PC + 768 + h * 64 + sc8);
      uint4 gq = *gp;
      float gt[8];
      unpack8(gq, gt);
      unsigned ow[4];
#pragma unroll
      for (int i = 0; i < 4; ++i) {
        float o0 = ((yv[2 * i] - mean) * rs * gnw[2 * i] + gnb[2 * i] + bon * vx[2 * i]) * silu(gt[2 * i]);
        float o1 = ((yv[2 * i + 1] - mean) * rs * gnw[2 * i + 1] + gnb[2 * i + 1] + bon * vx[2 * i + 1]) * silu(gt[2 * i + 1]);
        ow[i] = (unsigned)f2bf(o0) | ((unsigned)f2bf(o1) << 16);
      }
      if (!p.dry) *gp = make_uint4(ow[0], ow[1], ow[2], ow[3]);
    }
  }
#undef RW_ISSUE
  if (PASS == 1) {
    float* dst = (which == 0) ? Sl : Pm;
    if (!p.dry) {
#pragma unroll
      for (int r = 0; r < 4; ++r)
#pragma unroll
        for (int i = 0; i < 4; ++i)
          *(float4*)(dst + (rg * 4 + r) * 64 + q * 16 + i * 4) = make_float4(e[r][i * 2].x, e[r][i * 2].y, e[r][i * 2 + 1].x, e[r][i * 2 + 1].y);
    }
  }
}

__device__ __forceinline__ void rwkv_chain_item(const Params& p, int item, unsigned char* smem) {
  const int tid = tidx();
  const int bh = item >> 2, rg = item & 3;
  const int lr = tid >> 4, row = rg * 16 + lr, cq = tid & 15;
  float* srow = (float*)smem;
  float* sP = srow + 1024;
  float* SlB = (float*)(p.ws + OFF_RSL) + ((size_t)(bh * NSEG)) * 4096;
  const float* PmB = (const float*)(p.ws + OFF_RPM) + ((size_t)(bh * NSEG)) * 4096;
  float4 cur = make_float4(0.f, 0.f, 0.f, 0.f);
  float4 a0, a1, a2, a3, al, b0, b1, b2, b3, bl, c0, c1, c2, c3, cl, d0, d1, d2, d3, dl;
#define CH_LOAD(X, sg)                                                         \
  {                                                                            \
    const float4* nP = (const float4*)(PmB + (size_t)(sg) * 4096);             \
    X##0 = nP[tid]; X##1 = nP[tid + 256]; X##2 = nP[tid + 512]; X##3 = nP[tid + 768]; \
    X##l = *(const float4*)(SlB + (size_t)(sg) * 4096 + row * 64 + cq * 4);    \
  }
#define CH_STEP(X, Y, sg)                                                      \
  {                                                                            \
    ((float4*)sP)[tid] = X##0; ((float4*)sP)[tid + 256] = X##1;                \
    ((float4*)sP)[tid + 512] = X##2; ((float4*)sP)[tid + 768] = X##3;          \
    *(float4*)(srow + lr * 64 + cq * 4) = cur;                                 \
    float4 nx = X##l;                                                          \
    __syncthreads();                                                           \
    if (!p.dry) { *(float4*)(SlB + (size_t)(sg) * 4096 + row * 64 + cq * 4) = cur; } \
    if ((sg) + 3 < NSEG) CH_LOAD(Y, (sg) + 3);                                 \
    _Pragma("unroll 16") for (int j = 0; j < 64; ++j) {                        \
      float sv_ = srow[lr * 64 + j];                                           \
      float4 pm = *(const float4*)(sP + j * 64 + cq * 4);                      \
      nx.x += sv_ * pm.x; nx.y += sv_ * pm.y; nx.z += sv_ * pm.z; nx.w += sv_ * pm.w; \
    }                                                                          \
    __syncthreads();                                                           \
    cur = nx;                                                                  \
  }
  CH_LOAD(a, 0);
  CH_LOAD(b, 1);
  CH_LOAD(c, 2);
  d0 = d1 = d2 = d3 = dl = cur;
  __syncthreads();
#pragma unroll 1
  for (int seg = 0; seg < NSEG; seg += 4) {
    CH_STEP(a, d, seg);
    CH_STEP(b, a, seg + 1);
    CH_STEP(c, b, seg + 2);
    CH_STEP(d, c, seg + 3);
  }
#undef CH_LOAD
#undef CH_STEP
}

__device__ __forceinline__ void memattn_item(const Params& p, int l, int b, int h, int tile, unsigned char* smem) {
  u16* P = (u16*)(p.ws + OFF_P);
  const int tid = tidx(), lane = tid & 63, w = tid >> 6, fr = lane & 15, fq = lane >> 4;
  u16* pw = (u16*)smem + w * (16 * 264);
  const u16* km = (const u16*)(p.ws + OFF_KM) + (size_t)l * 1024 * 256 + (size_t)b * 256 * 256 + h * 64;
  const u16* vmT = (const u16*)(p.ws + OFF_VMT) + (size_t)l * 4 * 256 * 256 + ((size_t)b * 256 + h * 64) * 256;
  const size_t tok0 = (size_t)b * SEQ + tile * 64 + w * 16;
  __syncthreads();
  f32x4 acc[16];
#pragma unroll
  for (int n = 0; n < 16; ++n) acc[n] = f32x4{0.f, 0.f, 0.f, 0.f};
  {
    const u16* Aq = P + tok0 * PC + C_MQ + h * 64;
    bf16x8 a0 = *(const bf16x8*)(Aq + fr * PC + fq * 8);
    bf16x8 a1 = *(const bf16x8*)(Aq + fr * PC + 32 + fq * 8);
#pragma unroll
    for (int n4 = 0; n4 < 4; ++n4) {
#pragma unroll
      for (int nn = 0; nn < 4; ++nn) {
        int n = n4 * 4 + nn;
        bf16x8 b0 = *(const bf16x8*)(km + (n * 16 + fr) * 256 + fq * 8);
        bf16x8 b1 = *(const bf16x8*)(km + (n * 16 + fr) * 256 + 32 + fq * 8);
        acc[n] = __builtin_amdgcn_mfma_f32_16x16x32_bf16(b0, a0, acc[n], 0, 0, 0);
        acc[n] = __builtin_amdgcn_mfma_f32_16x16x32_bf16(b1, a1, acc[n], 0, 0, 0);
      }
      __builtin_amdgcn_sched_barrier(0);
    }
  }
  {
    float mx = -1e30f;
#pragma unroll
    for (int n = 0; n < 16; ++n)
#pragma unroll
      for (int j = 0; j < 4; ++j) mx = fmaxf(mx, acc[n][j]);
    mx = fmaxf(mx, __shfl_xor(mx, 16, 64));
    mx = fmaxf(mx, __shfl_xor(mx, 32, 64));
    float sm = 0.f;
#pragma unroll
    for (int n = 0; n < 16; ++n)
#pragma unroll
      for (int j = 0; j < 4; ++j) { float ev = __expf((acc[n][j] - mx) * 0.125f); acc[n][j] = ev; sm += ev; }
    sm += __shfl_xor(sm, 16, 64);
    sm += __shfl_xor(sm, 32, 64);
    const float inv = 1.f / sm;
#pragma unroll
    for (int n = 0; n < 16; ++n)
      *(uint2*)(pw + fr * 264 + n * 16 + fq * 4) = pack4(acc[n][0] * inv, acc[n][1] * inv, acc[n][2] * inv, acc[n][3] * inv);
  }
  __syncthreads();
  f32x4 o[4];
#pragma unroll
  for (int n = 0; n < 4; ++n) o[n] = f32x4{0.f, 0.f, 0.f, 0.f};
  mma_strip_t<4, 8>(pw, 264, vmT, 256, o);
#pragma unroll
  for (int n = 0; n < 4; ++n) {
    uint2* gp = (uint2*)(P + (tok0 + fr) * PC + 1024 + h * 64 + n * 16 + fq * 4);
    float g[4];
    unpack4(*gp, g);
    if (!p.dry) *gp = pack4(o[n][0] * silu(g[0]), o[n][1] * silu(g[1]), o[n][2] * silu(g[2]), o[n][3] * silu(g[3]));
  }
}

__device__ __forceinline__ void ln_item(const Params& p, int l, int item) {
  const int lane = tidx() & 63, w = tidx() >> 6;
  const size_t row = (size_t)item * 4 + w;
  float4* x = (float4*)(p.out + row * 1024);
  float4 v[4];
  float s = 0.f;
#pragma unroll
  for (int i = 0; i < 4; ++i) { v[i] = x[lane + 64 * i]; s += v[i].x + v[i].y + v[i].z + v[i].w; }
  s = wave_sum(s);
  const float mean = s * (1.f / 1024.f);
  float s2 = 0.f;
#pragma unroll
  for (int i = 0; i < 4; ++i) {
    float a = v[i].x - mean, b = v[i].y - mean, c = v[i].z - mean, d = v[i].w - mean;
    s2 += a * a + b * b + c * c + d * d;
  }
  s2 = wave_sum(s2);
  const float rs = rsqrtf(s2 * (1.f / 1024.f) + 1e-5f);
  const float4* lw = (const float4*)(p.in[I_LNW] + l * 1024);
  const float4* lb = (const float4*)(p.in[I_LNB] + l * 1024);
#pragma unroll
  for (int i = 0; i < 4; ++i) {
    float4 wv = lw[lane + 64 * i], bv = lb[lane + 64 * i], o;
    o.x = (v[i].x - mean) * rs * wv.x + bv.x;
    o.y = (v[i].y - mean) * rs * wv.y + bv.y;
    o.z = (v[i].z - mean) * rs * wv.z + bv.z;
    o.w = (v[i].w - mean) * rs * wv.w + bv.w;
    if (!p.dry) {
      x[lane + 64 * i] = o;
      if (l + 1 < NL) {
        uint2 ov;
        ov.x = (unsigned)f2bf(o.x) | ((unsigned)f2bf(o.y) << 16);
        ov.y = (unsigned)f2bf(o.z) | ((unsigned)f2bf(o.w) << 16);
        ((uint2*)((u16*)(p.ws + OFF_PREP) + row * 1024))[lane + 64 * i] = ov;
      }
    }
  }
}

__device__ __forceinline__ unsigned touch_gla(const Params& p, int tn, bool out) {
  if (tn >= 2048) return 0u;
  const u16* P = (const u16*)(p.ws + OFF_P);
  const int tid = tidx(), s = tid & 63, wq = tid >> 6;
  const int b = tn >> 9, c = (tn >> 2) & 127, h = tn & 3;
  const size_t tok0 = (size_t)b * SEQ + c * 64;
  const int col = (wq == 0 ? C_GQ : wq == 1 ? C_GK : wq == 2 ? C_GV : C_GA) + (wq < 3 ? h * 64 : 0);
  unsigned r = *(const unsigned*)(P + (tok0 + s) * PC + col);
  if (out) {
    if (tid < 64) r ^= *(const unsigned*)((const u16*)(p.ws + OFF_GST) + ((size_t)((b * 128 + c) * 4 + h)) * 4096 + tid * 64);
    else if (tid >= 128 && tid < 192) r ^= *(const unsigned*)(P + (tok0 + tid - 128) * PC + h * 64);
  }
  return r;
}
__device__ __forceinline__ unsigned touch_ssd(const Params& p, int tn, bool out) {
  if (tn >= 2048) return 0u;
  const u16* P = (const u16*)(p.ws + OFF_P);
  const int tid = tidx(), s = tid & 63, wq = tid >> 6;
  const int b = tn >> 9, c = (tn >> 2) & 127, h = tn & 3, g = h >> 1;
  const size_t tok0 = (size_t)b * SEQ + c * 64;
  const int col = wq == 0 ? C_XBC + h * 64 : wq == 1 ? C_XBC + 256 + g * 64 : wq == 2 ? C_XBC + 384 + g * 64 : C_DT;
  unsigned r = *(const unsigned*)(P + (tok0 + s) * PC + col);
  if (out) {
    if (tid < 64) r ^= *(const unsigned*)((const u16*)(p.ws + OFF_SST) + ((size_t)((b * 128 + c) * 4 + h)) * 4096 + tid * 64);
    else if (tid >= 128 && tid < 192) r ^= *(const unsigned*)(P + (tok0 + tid - 128) * PC + 256 + h * 64);
  }
  return r;
}
__device__ __forceinline__ unsigned touch_s5(const Params& p, int tn) {
  if (tn >= 512) return 0u;
  const u16* P = (const u16*)(p.ws + OFF_P);
  const int tid = tidx();
  const size_t tok0 = (size_t)(tn >> 7) * SEQ + (tn & 127) * 64;
  return *(const unsigned*)(P + (tok0 + (tid >> 2)) * PC + C_S5U + (tid & 3) * 64);
}
__device__ __forceinline__ unsigned touch_prep(const Params& p, int tn) {
  if (tn >= 2048) return 0u;
  const u16* P = (const u16*)(p.ws + OFF_P);
  const int tid = tidx();
  const size_t tok0 = (size_t)tn * 16;
  if (tid < 238) return *(const unsigned*)(P + (tok0 - 1 + tid / 14) * PC + C_RW + (tid % 14) * 64);
  if (tid < 254) return *(const unsigned*)(P + (tok0 + tid - 238) * PC + C_VL);
  return 0u;
}
#define KEEP(x) asm volatile("" ::"v"(x))

#define FOR_ITEMS(N) for (int t = blockIdx.x; t < (N); t += gridDim.x)
#define RUNIT(bit, ...)                                                        \
  for (int rep_ = ((pq.probe >> (bit)) & 1) ? 0 : 1; rep_ < 2; ++rep_) {       \
    pq.dry = p.dry | (rep_ == 0);                                              \
    __VA_ARGS__                                                                \
  }
__device__ __forceinline__ void phaseB(const Params& p, int l, unsigned char* smem) {
  Params pq = p;
  RUNIT(8, FOR_ITEMS(2048) { unsigned pf = touch_prep(pq, t + gridDim.x); rwkv_prep_item(pq, l, t, smem); KEEP(pf); })
#define RM4(t_) ((gridDim.x == 512 && (t_) < 2048) ? ((((((t_) >> 9) * 64 + ((int)blockIdx.x >> 3)) >> 2) * 8 + ((int)blockIdx.x & 7)) << 2 | ((((t_) >> 9) * 64 + ((int)blockIdx.x >> 3)) & 3)) : (t_))
  RUNIT(9, FOR_ITEMS(2048) { const int u = RM4(t); const int un = RM4(t + (int)gridDim.x); unsigned pf = touch_gla(pq, un, false); gla_item<false>(pq, l, u >> 9, (u >> 2) & 127, u & 3, smem); KEEP(pf); })
  RUNIT(10, FOR_ITEMS(2048) { const int u = RM4(t); const int un = RM4(t + (int)gridDim.x); unsigned pf = touch_ssd(pq, un, false); ssd_item<false>(pq, l, u >> 9, (u >> 2) & 127, u & 3, smem); KEEP(pf); })
#undef RM4
  RUNIT(11, FOR_ITEMS(512) s5_item<false>(pq, l, t >> 7, t & 127, smem);)
}
__device__ __forceinline__ void phaseC(const Params& p, int l, unsigned char* smem) {
  Params pq = p;
  RUNIT(12, __syncthreads(); FOR_ITEMS(16 * NSEG * 2 / 4) {
    const int wv_ = tidx() >> 6;
    if (wv_ & 1) rwkv_scan_wave<1, false>(pq, l, t * 4 + wv_, (float*)smem + wv_ * 3072);
    else rwkv_scan_wave<1, true>(pq, l, t * 4 + wv_, (float*)smem + wv_ * 3072);
  })
  RUNIT(13, FOR_ITEMS(256) {
              if (t < 128) state_scan_item(pq, (u16*)(p.ws + OFF_GST), (const float*)(p.ws + OFF_GDC), t);
              else state_scan_item(pq, (u16*)(p.ws + OFF_SST), (const float*)(p.ws + OFF_SDC), t - 128);
            }
            FOR_ITEMS(16) s5_scan_item(pq, l, t);)
  RUNIT(14, FOR_ITEMS(2048) memattn_item(pq, l, t >> 9, (t >> 7) & 3, t & 127, smem);)
}
__device__ __forceinline__ void phaseD(const Params& p, int l, unsigned char* smem) {
  Params pq = p;
  const bool split = (gridDim.x == 512);
#define FOR_REST(N) for (int t = split ? (int)blockIdx.x - 64 : (int)blockIdx.x; t >= 0 && t < (N); t += split ? 448 : (int)gridDim.x)
  RUNIT(13, FOR_ITEMS(64) rwkv_chain_item(pq, t, smem);)
  const int rst = split ? 448 : (int)gridDim.x;
  RUNIT(9, FOR_REST(4608) {
    const int tn = t + rst;
    unsigned pf = (tn < 2048) ? touch_gla(pq, tn, true) : (tn < 4096) ? touch_ssd(pq, tn - 2048, true) : touch_s5(pq, tn - 4096);
    if (t < 2048) gla_item<true>(pq, l, t >> 9, (t >> 2) & 127, t & 3, smem);
    else if (t < 4096) { const int u = t - 2048; ssd_item<true>(pq, l, u >> 9, (u >> 2) & 127, u & 3, smem); }
    else { const int u = t - 4096; s5_item<true>(pq, l, u >> 7, u & 127, smem); }
    KEEP(pf);
  })
#undef FOR_REST
}
__device__ __forceinline__ void phaseE(const Params& p, int l, unsigned char* smem) {
  Params pq = p;
  RUNIT(15, __syncthreads(); FOR_ITEMS(16 * NSEG / 4) {
    rwkv_scan_wave<3, true>(pq, l, t * 4 + (tidx() >> 6), (float*)smem + (tidx() >> 6) * 3072);
  })
  RUNIT(16, for (int t = (gridDim.x == 512) ? ((int)blockIdx.x >= 256 ? (int)blockIdx.x - 256 : 512) : (int)blockIdx.x; t < 512;
                 t += (gridDim.x == 512) ? 256 : (int)gridDim.x) {
    int mt = t >> 1, nt = t & 1;
    gemm_tile<EPI_GLU, false>(pq, l, (const u16*)(p.ws + OFF_P) + C_S5U, PC, (const u16*)(p.ws + OFF_GLU) + (size_t)l * 512 * 256, 256, mt * 128, nt * 256, smem);
  })
  if (l + 1 < NL) {
    const float* src = p.in[I_WINR] + (size_t)l * 1024 * 4020;
    for (int t = (gridDim.x == 512) ? ((int)blockIdx.x >= 256 ? (int)blockIdx.x - 256 : 1024) : (int)blockIdx.x; t < 1024;
         t += (gridDim.x == 512) ? 256 : (int)gridDim.x)
      tconv_tile(src, 4020, (u16*)(p.ws + OFF_WIN), 1024, (t / 16) * 64, (t % 16) * 64, 0, l + 1, (float*)smem, p.dry);
  }
}
__device__ __forceinline__ void phaseF(const Params& p, int l, unsigned char* smem) {
  FOR_ITEMS(256 * 4) {
    int mt = t >> 2, nt = t & 3;
    if (gridDim.x == 512) {
      const int r = t >> 9, x = blockIdx.x & 7, k = blockIdx.x >> 3;
      mt = x * 32 + r * 16 + (k >> 2);
      nt = k & 3;
    }
    gemm_tile<EPI_OUT, false>(p, l, (const u16*)(p.ws + OFF_P), PC, (const u16*)(p.ws + OFF_WOUT) + (size_t)l * 1024 * 1280, 1280, mt * 128, nt * 256, smem);
  }
}
__device__ __forceinline__ void phaseG(const Params& p, int l, unsigned char* smem) {
  FOR_ITEMS(NTOK / 4) ln_item(p, l, t);
}


#define XB_TMO      128
#define XB_XCNT(j)  (256  + 64 * (j))
#define XB_XSUB(j)  (1280 + 64 * (j))
#define XB_XGEN(j)  (2304 + 64 * (j))
#define XB_TOP      3328
#define XB_TOPGEN   3392
#define XCD_BAR_WORDS 3456
#define XB_SPIN_CAP (1u << 22)
#define LAS __attribute__((address_space(3)))
__device__ __forceinline__ unsigned xb_ld(unsigned* p)              { return __hip_atomic_load(p, __ATOMIC_RELAXED, __HIP_MEMORY_SCOPE_AGENT); }
__device__ __forceinline__ unsigned xb_add(unsigned* p, unsigned v) { return __hip_atomic_fetch_add(p, v, __ATOMIC_RELAXED, __HIP_MEMORY_SCOPE_AGENT); }
__device__ __forceinline__ unsigned xb_xcc_id() { return (unsigned)__builtin_amdgcn_s_getreg((3 << 11) | 20) & 0xFu; }
#define XB_SPIN(cond, bar) do { unsigned _sp = 0; while (cond) { __builtin_amdgcn_s_sleep(1); \
    if ((++_sp & 255u) == 0u) { if (xb_ld(&(bar)[XB_TMO])) break; if (_sp > XB_SPIN_CAP) { atomicAdd(&(bar)[XB_TMO], 1u); break; } } } } while (0)
struct XcdBarrier { unsigned* bar; unsigned x; volatile LAS unsigned* st; };
__device__ __forceinline__ XcdBarrier xcd_barrier_post(unsigned* bar, volatile LAS unsigned* st) {
  XcdBarrier b; b.bar = bar; b.x = xb_xcc_id(); b.st = st;
  if (threadIdx.x == 0) (void)xb_add(&bar[XB_XCNT(b.x)], 1u);
  return b;
}
__device__ __forceinline__ void xcd_barrier_complete(unsigned* bar, unsigned x, unsigned& nloc, unsigned& nx) {
  const unsigned G = gridDim.x * gridDim.y * gridDim.z;
  unsigned sum, cnt, mine, sp = 0u;
  for (;;) {
    sum = 0u; cnt = 0u; mine = 0u;
#pragma unroll
    for (unsigned j = 0; j < 16; ++j) { const unsigned c = xb_ld(&bar[XB_XCNT(j)]); sum += c; cnt += (c > 0u) ? 1u : 0u; mine = (j == x) ? c : mine; }
    if (sum == G) break;
    __builtin_amdgcn_s_sleep(1);
    if ((++sp & 255u) == 0u) { if (xb_ld(&bar[XB_TMO])) break; if (sp > XB_SPIN_CAP) { atomicAdd(&bar[XB_TMO], 1u); break; } }
  }
  nloc = mine > 0u ? mine : 1u; nx = cnt > 0u ? cnt : 1u;
}
__device__ __forceinline__ void xcd_barrier(const XcdBarrier& b) {
  asm volatile("s_waitcnt vmcnt(0)" ::: "memory");
  __syncthreads();
  if (threadIdx.x == 0) {
    unsigned* bar = b.bar;
    __builtin_amdgcn_s_waitcnt(0);
    unsigned nloc = b.st[0], nx = b.st[1];
    if (nloc == 0u) { xcd_barrier_complete(bar, b.x, nloc, nx); b.st[0] = nloc; b.st[1] = nx; }
    const unsigned old = xb_add(&bar[XB_XSUB(b.x)], 1u);
    const unsigned gen = old / nloc;
    if (old + 1u == (gen + 1u) * nloc) {
      __builtin_amdgcn_fence(__ATOMIC_RELEASE, "agent");
      asm volatile("s_waitcnt vmcnt(0)" ::: "memory");
      const unsigned og = xb_add(&bar[XB_TOP], 1u);
      const unsigned tg = og / nx;
      if (og + 1u == (tg + 1u) * nx) xb_add(&bar[XB_TOPGEN], 1u);
      else XB_SPIN(xb_ld(&bar[XB_TOPGEN]) == tg, bar);
      __builtin_amdgcn_fence(__ATOMIC_ACQUIRE, "agent");
      xb_add(&bar[XB_XGEN(b.x)], 1u);
      asm volatile("s_waitcnt vmcnt(0)" ::: "memory");
    } else {
      XB_SPIN(xb_ld(&bar[XB_XGEN(b.x)]) == gen, bar);
      __builtin_amdgcn_fence(__ATOMIC_ACQUIRE, "agent");
      asm volatile("s_waitcnt vmcnt(0)" ::: "memory");
    }
  }
  __syncthreads();
}

#if MK_ONE
__global__ void __launch_bounds__(256, 2) mega_kernel(Params p) {
  __shared__ __attribute__((aligned(16))) unsigned char smem[SMEM_BYTES];
  cg::grid_group grid = cg::this_grid();
#ifndef PROBE_SYNC
#define PROBE_SYNC 0
#endif
#define GSYNC for (int sy_ = 0; sy_ <= PROBE_SYNC; ++sy_) xcd_barrier(xb)
  __shared__ uint4 xb_words;
  if (threadIdx.x == 0) xb_words = make_uint4(0u, 0u, 0u, 0u);
  __syncthreads();
  XcdBarrier xb = xcd_barrier_post((unsigned*)(p.ws + OFF_BAR), (volatile LAS unsigned*)&xb_words);
#ifndef TESTM
#define TESTM 255
#endif
#define RUNPH(bit, call)                                              \
  for (int rep = ((pp.probe >> (bit)) & 1) ? 0 : 1; rep < 2; ++rep) {  \
    pp.dry = (rep == 0);                                              \
    call;                                                             \
  }
  Params pp = p;
  RUNPH(0, phase0(pp, smem));
  GSYNC;
#pragma unroll 1
  for (int l = 0; l < NL; ++l) {
    RUNPH(1, phaseA(pp, l, smem)); GSYNC;
    RUNPH(2, phaseB(pp, l, smem)); GSYNC;
    RUNPH(3, phaseC(pp, l, smem)); GSYNC;
    RUNPH(4, phaseD(pp, l, smem)); GSYNC;
    RUNPH(5, phaseE(pp, l, smem)); GSYNC;
    RUNPH(6, phaseF(pp, l, smem));
    if (l + 1 < NL) GSYNC;
  }
  if (p.probe == 0x7fffffff) grid.sync();
}
#else
template <int PH>
__global__ void __launch_bounds__(256, 2) phase_kernel(Params p, int l) {
  __shared__ __attribute__((aligned(16))) unsigned char smem[SMEM_BYTES];
  if (PH == 0) phase0(p, smem);
  if (PH == 1) phaseA(p, l, smem);
  if (PH == 2) phaseB(p, l, smem);
  if (PH == 3) phaseC(p, l, smem);
  if (PH == 4) phaseD(p, l, smem);
  if (PH == 5) phaseE(p, l, smem);
  if (PH == 6) phaseF(p, l, smem);
  if (PH == 7) phaseG(p, l, smem);
}
#endif

extern "C" void kernel_launch(void* const* d_in, const int* in_sizes, int n_in, void* d_out, int out_size, void* d_ws,
                              size_t ws_size, hipStream_t stream) {
  Params p{};
  for (int i = 0; i < N_IN; ++i) p.in[i] = (const float*)d_in[i];
  p.out = (float*)d_out;
  p.ws = (unsigned char*)d_ws;
#ifndef PROBE_MASK
#define PROBE_MASK 0
#endif
  p.probe = PROBE_MASK;
  p.dry = 0;
  if (ws_size < WS_TOTAL) fprintf(stderr, "workspace too small: %zu < %zu\n", ws_size, (size_t)WS_TOTAL);
#if MK_ONE
  static int grid_blocks = 0;
  if (!grid_blocks) {
    int dev = 0, cus = 0, per_cu = 0;
    hipGetDevice(&dev);
    hipDeviceGetAttribute(&cus, hipDeviceAttributeMultiprocessorCount, dev);
    hipOccupancyMaxActiveBlocksPerMultiprocessor(&per_cu, mega_kernel, 256, 0);
    if (per_cu < 1) per_cu = 1;
    if (per_cu > 2) per_cu = 2;
    grid_blocks = cus * per_cu;
  }
  hipMemsetAsync((unsigned char*)d_ws + OFF_BAR, 0, 16384, stream);
  void* args[] = {&p};
  hipError_t e = hipLaunchCooperativeKernel((void*)mega_kernel, dim3(grid_blocks), dim3(256), args, 0, stream);
  if (e != hipSuccess) fprintf(stderr, "cooperative launch failed: %s (grid %d)\n", hipGetErrorString(e), grid_blocks);
#else
  const int G = 1024;
  phase_kernel<0><<<G, 256, 0, stream>>>(p, 0);
  for (int l = 0; l < NL; ++l) {
    phase_kernel<1><<<G, 256, 0, stream>>>(p, l);
    phase_kernel<2><<<G, 256, 0, stream>>>(p, l);
    phase_kernel<3><<<G, 256, 0, stream>>>(p, l);
    phase_kernel<4><<<G, 256, 0, stream>>>(p, l);
    phase_kernel<5><<<G, 256, 0, stream>>>(p, l);
    phase_kernel<6><<<G, 256, 0, stream>>>(p, l);
    phase_kernel<7><<<G, 256, 0, stream>>>(p, l);
  }
#endif
}
```
